# Optimizing an MI355X kernel written in HIP

```python
import jax, jax.numpy as jnp
from jax import lax
import numpy as np

D_MODEL = 2048
BATCH = 4
SEQ = 4096
DEPTH = 2

GDN_HEADS = 8
GDN_HEAD_DIM = 128
GDN_WIDTH = GDN_HEADS * GDN_HEAD_DIM
GDN_CHUNK = 64
CONV_WIDTH = 4
LRU_WIDTH = 1024
LRU_BLOCKS = 8
LRU_BLOCK_DIM = LRU_WIDTH // LRU_BLOCKS
LRU_C = 8.0
D_FF = 4 * D_MODEL
N_BRANCHES = 2
RMS_EPS = 1e-6
L2_EPS = 1e-6

SPLIT_SIZES = (3 * GDN_WIDTH, GDN_WIDTH, GDN_HEADS, GDN_HEADS, LRU_WIDTH, LRU_WIDTH, D_MODEL, D_MODEL)
IN_COLS = 3 * GDN_WIDTH + GDN_WIDTH + 2 * GDN_HEADS + 2 * LRU_WIDTH + N_BRANCHES * D_MODEL

kernel_name = 'hybrid_gdn_rglru_gated_merge'


def rms_norm(x, gain):
    xf = x.astype(jnp.float32)
    y = xf * lax.rsqrt(jnp.mean(xf * xf, axis=-1, keepdims=True) + RMS_EPS)
    return (y * gain.astype(jnp.float32)).astype(x.dtype)


def l2_normalize(x):
    return x * lax.rsqrt(jnp.sum(x * x, axis=-1, keepdims=True) + L2_EPS)


def causal_depthwise_conv(x, w):
    width = w.shape[0]
    seq = x.shape[1]
    xp = jnp.pad(x, ((0, 0), (width - 1, 0), (0, 0)))
    y = xp[:, 0:seq, :] * w[0]
    for j in range(1, width):
        y = y + xp[:, j:j + seq, :] * w[j]
    return y


def gated_delta_rule_chunked(q, k, v, g, beta):
    bsz, heads, seq, dk = q.shape
    dv = v.shape[-1]
    c = GDN_CHUNK
    n = seq // c
    q = q * (dk ** -0.5)

    def chunks(t):
        return t.reshape((bsz, heads, n, c) + t.shape[3:])

    q, k, v, g, beta = chunks(q), chunks(k), chunks(v), chunks(g), chunks(beta)
    g = jnp.cumsum(g, axis=-1)
    k_beta = k * beta[..., None]
    v_beta = v * beta[..., None]
    causal = jnp.tril(jnp.ones((c, c), dtype=bool))
    strict = jnp.tril(jnp.ones((c, c), dtype=bool), -1)
    diff = g[..., :, None] - g[..., None, :]
    decay = jnp.where(causal, jnp.exp(jnp.where(causal, diff, 0.0)), 0.0)
    lower = jnp.where(strict, jnp.einsum('bhnid,bhnjd->bhnij', k_beta, k) * decay, 0.0)
    eye = jnp.eye(c, dtype=q.dtype)
    t_inv = lax.linalg.triangular_solve(eye + lower, jnp.broadcast_to(eye, lower.shape),
                                        left_side=True, lower=True, unit_diagonal=True)
    u = jnp.einsum('bhnij,bhnjv->bhniv', t_inv, v_beta)
    w = jnp.einsum('bhnij,bhnjk->bhnik', t_inv, k_beta * jnp.exp(g)[..., None])
    qk = jnp.where(causal, jnp.einsum('bhnid,bhnjd->bhnij', q, k) * decay, 0.0)
    q_dec = q * jnp.exp(g)[..., None]
    g_last = g[..., -1]
    k_dec = k * jnp.exp(g_last[..., None] - g)[..., None]

    xs = (jnp.moveaxis(u, 2, 0), jnp.moveaxis(w, 2, 0), jnp.moveaxis(qk, 2, 0),
          jnp.moveaxis(q_dec, 2, 0), jnp.moveaxis(k_dec, 2, 0), jnp.moveaxis(g_last, 2, 0))

    def step(state, inp):
        u_n, w_n, qk_n, qd_n, kd_n, gl_n = inp
        v_new = u_n - jnp.einsum('bhck,bhkv->bhcv', w_n, state)
        out = (jnp.einsum('bhck,bhkv->bhcv', qd_n, state)
               + jnp.einsum('bhij,bhjv->bhiv', qk_n, v_new))
        state = state * jnp.exp(gl_n)[..., None, None] + jnp.einsum('bhck,bhcv->bhkv', kd_n, v_new)
        return state, out

    state0 = jnp.zeros((bsz, heads, dk, dv), dtype=q.dtype)
    _, out = lax.scan(step, state0, xs)
    return jnp.moveaxis(out, 0, 2).reshape(bsz, heads, seq, dv)


def gated_deltanet_branch(qkv, z, a, b, conv_w, a_log, dt_bias, norm_gain):
    bsz, seq, _ = qkv.shape
    f32 = jnp.float32
    qkv = jax.nn.silu(causal_depthwise_conv(qkv, conv_w))
    q, k, v = jnp.split(qkv, 3, axis=-1)

    def to_heads(t):
        return t.reshape(bsz, seq, GDN_HEADS, GDN_HEAD_DIM).transpose(0, 2, 1, 3).astype(f32)

    q = l2_normalize(to_heads(q))
    k = l2_normalize(to_heads(k))
    v = to_heads(v)
    g = -jnp.exp(a_log.astype(f32)) * jax.nn.softplus(a.astype(f32) + dt_bias.astype(f32))
    beta = jax.nn.sigmoid(b.astype(f32))
    o = gated_delta_rule_chunked(q, k, v, g.transpose(0, 2, 1), beta.transpose(0, 2, 1))
    o = rms_norm(o.transpose(0, 2, 1, 3), norm_gain)
    o = o.astype(z.dtype) * jax.nn.silu(z).reshape(bsz, seq, GDN_HEADS, GDN_HEAD_DIM)
    return o.reshape(bsz, seq, GDN_WIDTH)


def rglru_branch(xb, yb, conv_w, conv_b, w_gate_a, b_gate_a, w_gate_x, b_gate_x, lam):
    bsz, seq, _ = xb.shape
    f32 = jnp.float32
    xc = causal_depthwise_conv(xb, conv_w) + conv_b
    xh = xc.reshape(bsz, seq, LRU_BLOCKS, LRU_BLOCK_DIM)
    r = jax.nn.sigmoid(jnp.einsum('bsni,nij->bsnj', xh, w_gate_a).reshape(bsz, seq, LRU_WIDTH) + b_gate_a)
    i = jax.nn.sigmoid(jnp.einsum('bsni,nij->bsnj', xh, w_gate_x).reshape(bsz, seq, LRU_WIDTH) + b_gate_x)
    log_a = -LRU_C * r.astype(f32) * jax.nn.softplus(-lam.astype(f32))
    a = jnp.exp(log_a)
    bterm = jnp.sqrt(-jnp.expm1(2.0 * log_a)) * (i * xc).astype(f32)

    def combine(left, right):
        a_l, b_l = left
        a_r, b_r = right
        return a_l * a_r, a_r * b_l + b_r

    _, h = lax.associative_scan(combine, (a, bterm), axis=1)
    return h.astype(xb.dtype) * jax.nn.gelu(yb)


def hybrid_layer(x, attn_norm, w_in, gdn_conv_w, gdn_a_log, gdn_dt_bias, gdn_norm,
                 lru_conv_w, lru_conv_b, lru_w_a, lru_b_a, lru_w_x, lru_b_x, lru_lambda,
                 w_branch_gdn, w_branch_lru, w_out, mlp_norm, w_up, w_down):
    h = rms_norm(x, attn_norm)
    proj = h @ w_in
    offsets = []
    acc = 0
    for s in SPLIT_SIZES[:-1]:
        acc += s
        offsets.append(acc)
    qkv, z, a, b, xb, yb, gate_gdn, gate_lru = jnp.split(proj, offsets, axis=-1)
    o_gdn = gated_deltanet_branch(qkv, z, a, b, gdn_conv_w, gdn_a_log, gdn_dt_bias, gdn_norm)
    o_lru = rglru_branch(xb, yb, lru_conv_w, lru_conv_b, lru_w_a, lru_b_a, lru_w_x, lru_b_x, lru_lambda)
    merged = (jax.nn.sigmoid(gate_gdn) * (o_gdn @ w_branch_gdn)
              + jax.nn.sigmoid(gate_lru) * (o_lru @ w_branch_lru))
    x = x + merged @ w_out
    h = rms_norm(x, mlp_norm)
    x = x + jnp.square(jax.nn.relu(h @ w_up)) @ w_down
    return x


def setup_inputs(seed: int = 0) -> dict:
    key = jax.random.key(seed)
    ks = jax.random.split(key, 24)
    f32 = jnp.float32
    d, l = D_MODEL, DEPTH

    def normal(k, shape, scale):
        return jax.random.normal(k, shape, f32) * scale

    def gain(k, shape):
        return 1.0 + 0.02 * jax.random.normal(k, shape, f32)

    x = normal(ks[0], (BATCH, SEQ, d), 1.0)
    attn_norm = gain(ks[1], (l, d))
    w_in = normal(ks[2], (l, d, IN_COLS), d ** -0.5)
    gdn_conv_w = normal(ks[3], (l, CONV_WIDTH, 3 * GDN_WIDTH), CONV_WIDTH ** -0.5)
    gdn_a_log = jnp.log(jax.random.uniform(ks[4], (l, GDN_HEADS), f32, 1.0, 16.0))
    dt = jnp.exp(jax.random.uniform(ks[5], (l, GDN_HEADS), f32, np.log(1e-3), np.log(1e-1)))
    gdn_dt_bias = dt + jnp.log(-jnp.expm1(-dt))
    gdn_norm = gain(ks[6], (l, GDN_HEAD_DIM))
    lru_conv_w = normal(ks[7], (l, CONV_WIDTH, LRU_WIDTH), CONV_WIDTH ** -0.5)
    lru_conv_b = normal(ks[8], (l, LRU_WIDTH), 0.01)
    lru_w_a = normal(ks[9], (l, LRU_BLOCKS, LRU_BLOCK_DIM, LRU_BLOCK_DIM), LRU_BLOCK_DIM ** -0.5)
    lru_b_a = normal(ks[10], (l, LRU_WIDTH), 0.01)
    lru_w_x = normal(ks[11], (l, LRU_BLOCKS, LRU_BLOCK_DIM, LRU_BLOCK_DIM), LRU_BLOCK_DIM ** -0.5)
    lru_b_x = normal(ks[12], (l, LRU_WIDTH), 0.01)
    a0 = jax.random.uniform(ks[13], (l, LRU_WIDTH), f32, 0.9, 0.999)
    s0 = a0 ** (1.0 / LRU_C)
    lru_lambda = jnp.log(s0) - jnp.log1p(-s0)
    w_branch_gdn = normal(ks[14], (l, GDN_WIDTH, d), GDN_WIDTH ** -0.5)
    w_branch_lru = normal(ks[15], (l, LRU_WIDTH, d), LRU_WIDTH ** -0.5)
    w_out = normal(ks[16], (l, d, d), d ** -0.5)
    mlp_norm = gain(ks[17], (l, d))
    w_up = normal(ks[18], (l, d, D_FF), d ** -0.5)
    w_down = normal(ks[19], (l, D_FF, d), D_FF ** -0.5)
    final_norm = gain(ks[20], (d,))
    return {'x': x, 'attn_norm': attn_norm, 'w_in': w_in, 'gdn_conv_w': gdn_conv_w,
            'gdn_a_log': gdn_a_log, 'gdn_dt_bias': gdn_dt_bias, 'gdn_norm': gdn_norm,
            'lru_conv_w': lru_conv_w, 'lru_conv_b': lru_conv_b, 'lru_w_a': lru_w_a, 'lru_b_a': lru_b_a,
            'lru_w_x': lru_w_x, 'lru_b_x': lru_b_x, 'lru_lambda': lru_lambda,
            'w_branch_gdn': w_branch_gdn, 'w_branch_lru': w_branch_lru, 'w_out': w_out,
            'mlp_norm': mlp_norm, 'w_up': w_up, 'w_down': w_down, 'final_norm': final_norm}


def reference(x, attn_norm, w_in, gdn_conv_w, gdn_a_log, gdn_dt_bias, gdn_norm,
              lru_conv_w, lru_conv_b, lru_w_a, lru_b_a, lru_w_x, lru_b_x, lru_lambda,
              w_branch_gdn, w_branch_lru, w_out, mlp_norm, w_up, w_down, final_norm):
    for layer in range(DEPTH):
        x = hybrid_layer(x, attn_norm[layer], w_in[layer], gdn_conv_w[layer], gdn_a_log[layer],
                         gdn_dt_bias[layer], gdn_norm[layer], lru_conv_w[layer], lru_conv_b[layer],
                         lru_w_a[layer], lru_b_a[layer], lru_w_x[layer], lru_b_x[layer], lru_lambda[layer],
                         w_branch_gdn[layer], w_branch_lru[layer], w_out[layer], mlp_norm[layer],
                         w_up[layer], w_down[layer])
    return rms_norm(x, final_norm)
```

```cpp
#include <hip/hip_runtime.h>
#include <hip/hip_cooperative_groups.h>
#include <cstdio>
#include <cstdint>
namespace cg = cooperative_groups;

#ifndef PHMASK
#define PHMASK 0xFFFF
#endif
#ifndef REPMASK
#define REPMASK 0
#endif
#ifndef REPSEL
#define REPSEL 0
#endif
#define NREP(x) ((REPSEL == (x)) ? 2 : 1)
#ifndef ONE_LAUNCH
#define ONE_LAUNCH 1
#endif

#define LAS __attribute__((address_space(3)))
typedef unsigned short bf16_t;
typedef short bf16x8 __attribute__((ext_vector_type(8)));
typedef float f32x4 __attribute__((ext_vector_type(4)));
typedef float f32x2 __attribute__((ext_vector_type(2)));
typedef unsigned u32x4 __attribute__((ext_vector_type(4)));
typedef unsigned u32x2 __attribute__((ext_vector_type(2)));

#define LDS_WAIT() asm volatile("s_waitcnt lgkmcnt(0)" ::: "memory")

typedef __bf16 bf16x2_t __attribute__((ext_vector_type(2)));
__device__ __forceinline__ unsigned cvt_pk_bf16(float lo, float hi) { f32x2 v = {lo, hi}; bf16x2_t r = __builtin_convertvector(v, bf16x2_t); return __builtin_bit_cast(unsigned, r); }
__device__ __forceinline__ unsigned short bf16_1(float x) { return (unsigned short)(cvt_pk_bf16(x, 0.f) & 0xffffu); }
__device__ __forceinline__ float bflo(unsigned w) { return __uint_as_float(w << 16); }
__device__ __forceinline__ float bfhi(unsigned w) { return __uint_as_float(w & 0xffff0000u); }
__device__ __forceinline__ void unpack8(const u32x4 w, float* f) { f[0] = bflo(w.x); f[1] = bfhi(w.x); f[2] = bflo(w.y); f[3] = bfhi(w.y); f[4] = bflo(w.z); f[5] = bfhi(w.z); f[6] = bflo(w.w); f[7] = bfhi(w.w); }
__device__ __forceinline__ u32x4 pack8(const float* f) { u32x4 w; w.x = cvt_pk_bf16(f[0], f[1]); w.y = cvt_pk_bf16(f[2], f[3]); w.z = cvt_pk_bf16(f[4], f[5]); w.w = cvt_pk_bf16(f[6], f[7]); return w; }
__device__ __forceinline__ float sigmoidf_(float x) { return __builtin_amdgcn_rcpf(1.0f + __expf(-x)); }
__device__ __forceinline__ float siluf_(float x) { return x * sigmoidf_(x); }
__device__ __forceinline__ float gelu_tanh(float x) { const float u = 0.7978845608028654f * (x + 0.044715f * x * x * x); return x * sigmoidf_(2.0f * u); }
__device__ __forceinline__ float softplusf_(float x) { return x > 20.f ? x : log1pf(expf(x)); }
__device__ __forceinline__ float wave_sum(float v) {
#pragma unroll
    for (int o = 1; o < 64; o <<= 1) v += __shfl_xor(v, o);
    return v;
}


__device__ __forceinline__ void grid_bar(unsigned* ctr, const unsigned target, const int tid) {
    asm volatile("s_waitcnt vmcnt(0) lgkmcnt(0)" ::: "memory");
    __syncthreads();
    if (tid == 0) {
        __builtin_amdgcn_fence(__ATOMIC_RELEASE, "agent");
        asm volatile("s_waitcnt vmcnt(0)" ::: "memory");
        __hip_atomic_fetch_add(ctr, 1u, __ATOMIC_RELAXED, __HIP_MEMORY_SCOPE_AGENT);
        while (__hip_atomic_load(ctr, __ATOMIC_RELAXED, __HIP_MEMORY_SCOPE_AGENT) < target) __builtin_amdgcn_s_sleep(1);
        __builtin_amdgcn_fence(__ATOMIC_ACQUIRE, "agent");
        asm volatile("s_waitcnt vmcnt(0)" ::: "memory");
    }
    __syncthreads();
}


typedef __attribute__((address_space(1))) unsigned gu32;
#define XB_TMO      128
#define XB_XCNT(j)  (256  + 64 * (j))
#define XB_XSUB(j)  (1280 + 64 * (j))
#define XB_XGEN(j)  (2304 + 64 * (j))
#define XB_TOP      3328
#define XB_TOPGEN   3392
#define XCD_BAR_WORDS 3456
#define XB_SPIN_CAP (1u << 18)

__device__ __forceinline__ unsigned xb_ld(unsigned* p)              { return __hip_atomic_load(p, __ATOMIC_RELAXED, __HIP_MEMORY_SCOPE_AGENT); }
__device__ __forceinline__ unsigned xb_add(unsigned* p, unsigned v) { return __hip_atomic_fetch_add(p, v, __ATOMIC_RELAXED, __HIP_MEMORY_SCOPE_AGENT); }
__device__ __forceinline__ unsigned xb_xcc_id() { return (unsigned)__builtin_amdgcn_s_getreg((3 << 11) | 20) & 0xFu; }
#define XB_SPIN(cond, bar) do { unsigned _sp = 0; while (cond) { __builtin_amdgcn_s_sleep(1); \
    if ((++_sp & 255u) == 0u) { if (xb_ld(&(bar)[XB_TMO])) break; if (_sp > XB_SPIN_CAP) { atomicAdd(&(bar)[XB_TMO], 1u); break; } } } } while (0)

struct XcdBarrier {
    unsigned* bar; unsigned x;
    volatile LAS unsigned* st;
};

__device__ __forceinline__ XcdBarrier xcd_barrier_post(unsigned* bar, volatile LAS unsigned* st) {
    XcdBarrier b; b.bar = bar; b.x = xb_xcc_id(); b.st = st;
    if (threadIdx.x == 0) (void)xb_add(&bar[XB_XCNT(b.x)], 1u);
    return b;
}
__device__ __forceinline__ void xcd_barrier_complete(unsigned* bar, unsigned x, unsigned& nloc, unsigned& nx) {
    const unsigned G = gridDim.x * gridDim.y * gridDim.z;
    unsigned sum, cnt, mine, sp = 0u;
    for (;;) {
        sum = 0u; cnt = 0u; mine = 0u;
#pragma unroll
        for (unsigned j = 0; j < 16; ++j) { const unsigned c = xb_ld(&bar[XB_XCNT(j)]); sum += c; cnt += (c > 0u) ? 1u : 0u; mine = (j == x) ? c : mine; }
        if (sum == G) break;
        __builtin_amdgcn_s_sleep(1);
        if ((++sp & 255u) == 0u) { if (xb_ld(&bar[XB_TMO])) break; if (sp > XB_SPIN_CAP) { atomicAdd(&bar[XB_TMO], 1u); break; } }
    }
    nloc = mine > 0u ? mine : 1u; nx = cnt > 0u ? cnt : 1u;
}

__device__ __forceinline__ void xcd_barrier(const XcdBarrier& b) {
    asm volatile("s_waitcnt vmcnt(0)" ::: "memory");
    __syncthreads();
    if (threadIdx.x == 0) {
        unsigned* bar = b.bar;
        __builtin_amdgcn_s_waitcnt(0);
        unsigned nloc = b.st[0], nx = b.st[1];
        if (nloc == 0u) { xcd_barrier_complete(bar, b.x, nloc, nx); b.st[0] = nloc; b.st[1] = nx; }
        const unsigned old = xb_add(&bar[XB_XSUB(b.x)], 1u);
        const unsigned gen = old / nloc;
        if (old + 1u == (gen + 1u) * nloc) {
            __builtin_amdgcn_fence(__ATOMIC_RELEASE, "agent");
            asm volatile("s_waitcnt vmcnt(0)" ::: "memory");
            const unsigned og = xb_add(&bar[XB_TOP], 1u);
            const unsigned tg = og / nx;
            if (og + 1u == (tg + 1u) * nx) xb_add(&bar[XB_TOPGEN], 1u);
            else XB_SPIN(xb_ld(&bar[XB_TOPGEN]) == tg, bar);
            __builtin_amdgcn_fence(__ATOMIC_ACQUIRE, "agent");
            xb_add(&bar[XB_XGEN(b.x)], 1u);
            asm volatile("s_waitcnt vmcnt(0)" ::: "memory");
        } else {
            XB_SPIN(xb_ld(&bar[XB_XGEN(b.x)]) == gen, bar);
            __builtin_amdgcn_fence(__ATOMIC_ACQUIRE, "agent");
            asm volatile("s_waitcnt vmcnt(0)" ::: "memory");
        }
    }
    __syncthreads();
}


namespace pg8 {
constexpr int BM = 256, BK = 64, HALF = 128, HTB = HALF * BK * 2, STAGE_BYTES = 8 * HTB, NXCD = 8, WGM = 8;
__host__ __device__ __forceinline__ int lds_byte(int r, int c) { const int st = (r >> 4) * 2 + (c >> 5), rr = r & 15, cc = c & 31, ob = rr * 64 + cc * 2; return st * 1024 + (ob ^ (((ob >> 9) & 1) << 5)); }
__host__ __device__ __forceinline__ void stage_rc(int b, int& R, int& C) { const int st = b / 1024, sb = b % 1024, swz = sb ^ (((sb >> 9) & 1) << 5); R = (st >> 1) * 16 + swz / 64; C = (st & 1) * 32 + (swz % 64) / 2; }
__host__ __device__ __forceinline__ int perm32(int rho) { const int n = rho >> 4, i = rho & 15; return 8 * (i >> 2) + 4 * n + (i & 3); }

struct Unit { int pm, pn; };
struct Gemm { const bf16_t* A; const bf16_t* Bt; int M, N, K; };

struct StaticOrder {
    int nM, nN, nwg, G, c;
    __host__ __device__ void init(int M, int N, int G_, int c_) { nM = M / BM; nN = N / BM; nwg = nM * nN; G = G_; c = c_; }
    __host__ __device__ bool next(int i, Unit& u) const {
        const long L = (long)i * G + c; if (L >= nwg) return false;
        int wgid = (int)L; { const int q = nwg / NXCD, r = nwg % NXCD, xcd = wgid % NXCD, off = wgid / NXCD; wgid = (xcd < r ? xcd * (q + 1) : r * (q + 1) + (xcd - r) * q) + off; }
        const int nig = WGM * nN, gid = wgid / nig, fm = gid * WGM, gsz = (nM - fm) < WGM ? (nM - fm) : WGM;
        u.pm = fm + ((wgid % nig) % gsz); u.pn = (wgid % nig) / gsz; return true;
    }
    __device__ __forceinline__ void a_ready(const Unit&) const {}
    __device__ __forceinline__ void done(const Unit&) const {}
};

template <class Epi, class Sched, bool ALIGN_EPI = false, bool SP2 = false>
__device__ __forceinline__ void gemm_phase(LAS unsigned char* lds, const Gemm g, const Sched& S, const Epi& E, const int tid_) {
    const int tid = tid_, wid = __builtin_amdgcn_readfirstlane(tid >> 6), lane = tid & 63, wr = wid >> 2, wc = wid & 3, fr = lane & 15, fq = lane >> 4;
    const int K = g.K, nt = K / BK;
    unsigned voffA[2], voffB[2];
#pragma unroll
    for (int i = 0; i < 2; ++i) { int R, C; stage_rc(tid * 16 + i * 8192, R, C); const int Rb = Epi::PERM ? ((R & ~31) + perm32(R & 31)) : R;
        voffA[i] = (unsigned)(R * K + C) * 2u; voffB[i] = (unsigned)(Rb * K + C) * 2u; }
    const size_t kstep = (size_t)(BK * 2);
    const size_t hstep = (size_t)HALF * K * 2;
    const size_t tstep = 2 * hstep;
    const unsigned ldsw = (unsigned)wid * 1024u;
    const int aoff = lds_byte(wr * 64 + fr, fq * 8), boff = lds_byte(wc * 32 + fr, fq * 8);
#define PG8_SA(b, h) (((b) * 2 + (h)) * HTB)
#define PG8_SB(b, h) ((4 + (b) * 2 + (h)) * HTB)
#define PG8_STAGE(bufoff, gbase, voff) do { _Pragma("unroll") for (int _i = 0; _i < 2; ++_i) \
        __builtin_amdgcn_global_load_lds((const unsigned*)((const char*)(gbase) + (voff)[_i]), (LAS unsigned*)(lds + (bufoff) + ldsw + _i * 8192), 16, 0, 0); } while (0)
#define PG8_LDA(dst, b, h) do { _Pragma("unroll") for (int m = 0; m < 4; ++m) _Pragma("unroll") for (int k = 0; k < 2; ++k) dst[m][k] = *(const LAS bf16x8*)(lds + PG8_SA(b, h) + aoff + m * 2048 + k * 1024); } while (0)
#define PG8_LDB(dst, b, h) do { _Pragma("unroll") for (int n = 0; n < 2; ++n) _Pragma("unroll") for (int k = 0; k < 2; ++k) dst[n][k] = *(const LAS bf16x8*)(lds + PG8_SB(b, h) + boff + n * 2048 + k * 1024); } while (0)
#define PG8_MMA(ai, bj, At, Bt) do { __builtin_amdgcn_s_setprio(1); _Pragma("unroll") for (int m = 0; m < 4; ++m) _Pragma("unroll") for (int n = 0; n < 2; ++n) _Pragma("unroll") for (int k = 0; k < 2; ++k) \
        acc[ai][bj][m][n] = __builtin_amdgcn_mfma_f32_16x16x32_bf16(Bt[n][k], At[m][k], acc[ai][bj][m][n], 0, 0, 0); __builtin_amdgcn_s_setprio(0); } while (0)
#define PG8_WAIT_V(n) asm volatile("s_waitcnt vmcnt(" #n ")" ::: "memory")
#define PG8_WAIT_L(n) asm volatile("s_waitcnt lgkmcnt(" #n ")" ::: "memory")
#define PG8_BAR __builtin_amdgcn_s_barrier()
#define PG8_SCHED __builtin_amdgcn_sched_barrier(0)
    Unit cur, nxt; int ui = 0;
    if (!S.next(0, cur)) return;
    f32x4 acc[2][2][4][2];
#pragma unroll
    for (int a = 0; a < 2; ++a)
#pragma unroll
        for (int b = 0; b < 2; ++b)
#pragma unroll
            for (int m = 0; m < 4; ++m)
#pragma unroll
                for (int n = 0; n < 2; ++n) acc[a][b][m][n] = (f32x4){0.f, 0.f, 0.f, 0.f};
    bf16x8 At[4][2], B0[2][2], B1[2][2];
    const char* cA = (const char*)g.A + (size_t)cur.pm * tstep; const char* cB = (const char*)g.Bt + (size_t)cur.pn * tstep;
    S.a_ready(cur);
    if constexpr (SP2) {
        PG8_STAGE(PG8_SB(0, 0), cB, voffB); PG8_STAGE(PG8_SB(0, 1), cB + hstep, voffB); PG8_STAGE(PG8_SA(0, 0), cA, voffA); PG8_STAGE(PG8_SA(0, 1), cA + hstep, voffA);
        if (wr == 1) PG8_BAR;
        PG8_WAIT_V(2); PG8_BAR;
        PG8_STAGE(PG8_SB(1, 0), cB + kstep, voffB); PG8_STAGE(PG8_SA(1, 0), cA + kstep, voffA); PG8_STAGE(PG8_SB(1, 1), cB + hstep + kstep, voffB);
        PG8_WAIT_V(6); PG8_BAR;
    } else {
        PG8_STAGE(PG8_SB(0, 0), cB, voffB); PG8_STAGE(PG8_SA(0, 0), cA, voffA); PG8_STAGE(PG8_SB(0, 1), cB + hstep, voffB); PG8_STAGE(PG8_SA(0, 1), cA + hstep, voffA);
        if (wr == 1) PG8_BAR;
        PG8_WAIT_V(4); PG8_BAR;
        PG8_STAGE(PG8_SB(1, 0), cB + kstep, voffB); PG8_STAGE(PG8_SA(1, 0), cA + kstep, voffA); PG8_STAGE(PG8_SB(1, 1), cB + hstep + kstep, voffB);
        PG8_WAIT_V(6); PG8_BAR;
    }
    for (;;) {
        const bool has_next = S.next(ui + 1, nxt);
        const char* nA = has_next ? (const char*)g.A + (size_t)nxt.pm * tstep : cA; const char* nB = has_next ? (const char*)g.Bt + (size_t)nxt.pn * tstep : cB;
        for (int t = 0; t < nt; t += 2) {
            const bool last = (t == nt - 2);
            const char* a1 = cA + (size_t)(t + 1) * kstep;
            const char* a2 = last ? nA : cA + (size_t)(t + 2) * kstep; const char* b2 = last ? nB : cB + (size_t)(t + 2) * kstep;
            const char* a3 = a2 + kstep; const char* b3 = b2 + kstep;
            if (last && has_next) S.a_ready(nxt);
            if constexpr (SP2) {
            PG8_LDB(B0, 0, 0); PG8_LDB(B1, 0, 1); PG8_SCHED; PG8_LDA(At, 0, 0); PG8_STAGE(PG8_SA(1, 1), a1 + hstep, voffA);
            PG8_WAIT_V(8); PG8_WAIT_L(0); PG8_BAR; PG8_MMA(0, 0, At, B0); PG8_MMA(0, 1, At, B1); PG8_BAR; PG8_SCHED;
            PG8_LDA(At, 0, 1); PG8_STAGE(PG8_SB(0, 0), b2, voffB); PG8_STAGE(PG8_SB(0, 1), b2 + hstep, voffB); PG8_STAGE(PG8_SA(0, 0), a2, voffA);
            PG8_WAIT_V(8); PG8_WAIT_L(0); PG8_BAR; PG8_MMA(1, 0, At, B0); PG8_MMA(1, 1, At, B1); PG8_BAR; PG8_SCHED;
            PG8_LDB(B0, 1, 0); PG8_LDB(B1, 1, 1); PG8_SCHED; PG8_LDA(At, 1, 0); PG8_STAGE(PG8_SA(0, 1), a2 + hstep, voffA);
            PG8_WAIT_V(8); PG8_WAIT_L(0); PG8_BAR; PG8_MMA(0, 0, At, B0); PG8_MMA(0, 1, At, B1); PG8_BAR; PG8_SCHED;
            PG8_LDA(At, 1, 1); PG8_STAGE(PG8_SB(1, 0), b3, voffB); PG8_STAGE(PG8_SB(1, 1), b3 + hstep, voffB); PG8_STAGE(PG8_SA(1, 0), a3, voffA);
            PG8_WAIT_V(8); PG8_WAIT_L(0); PG8_BAR; PG8_MMA(1, 0, At, B0); PG8_MMA(1, 1, At, B1); PG8_BAR; PG8_SCHED;
            } else {
            PG8_LDB(B0, 0, 0); PG8_SCHED; PG8_LDA(At, 0, 0); PG8_STAGE(PG8_SA(1, 1), a1 + hstep, voffA);
            PG8_WAIT_L(8); PG8_BAR; PG8_WAIT_L(0); PG8_MMA(0, 0, At, B0); PG8_BAR; PG8_SCHED;
            PG8_LDB(B1, 0, 1); PG8_STAGE(PG8_SB(0, 0), b2, voffB);
            PG8_BAR; PG8_WAIT_L(0); PG8_MMA(0, 1, At, B1); PG8_BAR;
            PG8_LDA(At, 0, 1); PG8_STAGE(PG8_SA(0, 0), a2, voffA);
            PG8_BAR; PG8_WAIT_L(0); PG8_MMA(1, 0, At, B0); PG8_BAR; PG8_SCHED;
            PG8_STAGE(PG8_SB(0, 1), b2 + hstep, voffB);
            PG8_WAIT_V(6); PG8_BAR; PG8_MMA(1, 1, At, B1); PG8_BAR;
            PG8_LDB(B0, 1, 0); PG8_SCHED; PG8_LDA(At, 1, 0); PG8_STAGE(PG8_SA(0, 1), a2 + hstep, voffA);
            PG8_WAIT_L(8); PG8_BAR; PG8_WAIT_L(0); PG8_MMA(0, 0, At, B0); PG8_BAR; PG8_SCHED;
            PG8_LDB(B1, 1, 1); PG8_STAGE(PG8_SB(1, 0), b3, voffB);
            PG8_BAR; PG8_WAIT_L(0); PG8_MMA(0, 1, At, B1); PG8_BAR;
            PG8_LDA(At, 1, 1); PG8_STAGE(PG8_SA(1, 0), a3, voffA);
            PG8_BAR; PG8_WAIT_L(0); PG8_MMA(1, 0, At, B0); PG8_BAR; PG8_SCHED;
            PG8_STAGE(PG8_SB(1, 1), b3 + hstep, voffB);
            PG8_WAIT_V(6); PG8_BAR; PG8_MMA(1, 1, At, B1); PG8_BAR;
            }
        }
        if constexpr (ALIGN_EPI) { if (wr == 0) PG8_BAR; }
        E(acc, cur, wr, wc, fr, fq); S.done(cur);
        if (!has_next) break;
#pragma unroll
        for (int a = 0; a < 2; ++a)
#pragma unroll
            for (int b = 0; b < 2; ++b)
#pragma unroll
                for (int m = 0; m < 4; ++m)
#pragma unroll
                    for (int n = 0; n < 2; ++n) acc[a][b][m][n] = (f32x4){0.f, 0.f, 0.f, 0.f};
        cur = nxt; cA = nA; cB = nB; ++ui;
        if constexpr (ALIGN_EPI) { if (wr == 1) PG8_BAR; }
    }
    PG8_WAIT_V(0);
    if constexpr (!ALIGN_EPI) { if (wr == 0) PG8_BAR; }
    PG8_BAR;
#undef PG8_SA
#undef PG8_SB
#undef PG8_STAGE
#undef PG8_LDA
#undef PG8_LDB
#undef PG8_MMA
#undef PG8_WAIT_V
#undef PG8_WAIT_L
#undef PG8_BAR
#undef PG8_SCHED
}
}

constexpr int T_ = 16384, D_ = 2048, SEQ_ = 4096, NPROJ = 10240, INC = 10256, DFF = 8192;
constexpr size_t MiB = (size_t)1 << 20;
constexpr size_t WS_G = 0;
constexpr size_t WS_BETA = MiB / 2;
constexpr size_t WS_AGGA = 1 * MiB;
constexpr size_t WS_AGGB = 2 * MiB;
__device__ __forceinline__ size_t WS_LWA_(int l) { return l ? 144 * MiB : 3 * MiB; }
__device__ __forceinline__ size_t WS_LWX_(int l) { return l ? 144 * MiB + 512 * 1024 : 3 * MiB + 512 * 1024; }
__device__ __forceinline__ size_t WS_WOUT_(int l) { return l ? 128 * MiB : 8 * MiB; }
__device__ __forceinline__ size_t WS_WBG_(int l) { return l ? 136 * MiB : 16 * MiB; }
__device__ __forceinline__ size_t WS_WBL_(int l) { return l ? 140 * MiB : 20 * MiB; }
__device__ __forceinline__ size_t WS_WIN_(int l) { return l ? 88 * MiB : 536 * MiB; }
constexpr size_t WS_CTL = 5 * MiB;
constexpr size_t WS_EGL = 4 * MiB;
constexpr size_t WS_H = 152 * MiB;
constexpr size_t WS_U = 152 * MiB, WS_W = 184 * MiB, WS_MG = 152 * MiB;
constexpr size_t WS_QKV = 216 * MiB;
constexpr size_t WS_Z = 312 * MiB;
constexpr size_t WS_XB = 344 * MiB;
constexpr size_t WS_YB = 376 * MiB;
constexpr size_t WS_SG = 408 * MiB;
constexpr size_t WS_ORAW = 280 * MiB;
constexpr size_t WS_OG = 216 * MiB, WS_OL = 248 * MiB;
constexpr size_t WS_UF = 216 * MiB;
constexpr size_t WS_QD = 536 * MiB, WS_KDT = 568 * MiB, WS_QK = 600 * MiB;
constexpr size_t WS_WUP = 24 * MiB, WS_WDN = 56 * MiB;
constexpr size_t WS_END = 616 * MiB;
constexpr int LDS_BYTES = 131072 + 4096;

struct Args { const float* in[21]; float* out; unsigned char* ws; int ph_lo, ph_hi; };
typedef const __attribute__((address_space(4))) Args* KA;

struct EpiProj {
    static constexpr bool PERM = true;
    unsigned char* ws;
    __device__ __forceinline__ void operator()(const f32x4 (&acc)[2][2][4][2], const pg8::Unit& u, int wr, int wc, int fr, int fq) const {
        const int pn = u.pn; bf16_t* base; int ldc, colt; bool sig = false;
        if (pn < 12) { base = (bf16_t*)(ws + WS_QKV); ldc = 3072; colt = pn * 256; }
        else if (pn < 16) { base = (bf16_t*)(ws + WS_Z); ldc = 1024; colt = (pn - 12) * 256; }
        else if (pn < 20) { base = (bf16_t*)(ws + WS_XB); ldc = 1024; colt = (pn - 16) * 256; }
        else if (pn < 24) { base = (bf16_t*)(ws + WS_YB); ldc = 1024; colt = (pn - 20) * 256; }
        else { base = (bf16_t*)(ws + WS_SG); ldc = 4096; colt = (pn - 24) * 256; sig = true; }
        const int row0 = u.pm * 256 + wr * 64 + fr, col0 = colt + wc * 32 + 8 * fq;
#pragma unroll
        for (int ai = 0; ai < 2; ++ai)
#pragma unroll
            for (int m = 0; m < 4; ++m) { bf16_t* rowp = base + (size_t)(row0 + ai * 128 + m * 16) * ldc + col0;
#pragma unroll
                for (int bj = 0; bj < 2; ++bj) { f32x4 v0 = acc[ai][bj][m][0], v1 = acc[ai][bj][m][1];
                    if (sig) {
#pragma unroll
                        for (int j = 0; j < 4; ++j) { v0[j] = sigmoidf_(v0[j]); v1[j] = sigmoidf_(v1[j]); } }
                    u32x4 w; w.x = cvt_pk_bf16(v0[0], v0[1]); w.y = cvt_pk_bf16(v0[2], v0[3]); w.z = cvt_pk_bf16(v1[0], v1[1]); w.w = cvt_pk_bf16(v1[2], v1[3]);
                    *(u32x4*)(rowp + bj * 128) = w; } }
    }
};
struct EpiNull { static constexpr bool PERM = true; float* o;
    __device__ __forceinline__ void operator()(const f32x4 (&acc)[2][2][4][2], const pg8::Unit& u, int wr, int wc, int fr, int fq) const { if (acc[0][0][0][0][0] == 12345.678f) o[0] = 1.f; } };
struct EpiGate {
    static constexpr bool PERM = true;
    const bf16_t* sg; bf16_t* mg; int add;
    __device__ __forceinline__ void operator()(const f32x4 (&acc)[2][2][4][2], const pg8::Unit& u, int wr, int wc, int fr, int fq) const {
        const int row0 = u.pm * 256 + wr * 64 + fr, col0 = u.pn * 256 + wc * 32 + 8 * fq;
#pragma unroll
        for (int ai = 0; ai < 2; ++ai) {
            u32x4 gwv[4][2], pwv[4][2];
#pragma unroll
            for (int m = 0; m < 4; ++m) { const size_t r = (size_t)(row0 + ai * 128 + m * 16);
#pragma unroll
                for (int bj = 0; bj < 2; ++bj) { gwv[m][bj] = *(const u32x4*)(sg + r * 4096 + col0 + bj * 128);
                    pwv[m][bj] = add ? *(const u32x4*)(mg + r * 2048 + col0 + bj * 128) : (u32x4){0u, 0u, 0u, 0u}; } }
            asm volatile("" ::: "memory");
#pragma unroll
            for (int m = 0; m < 4; ++m) { const size_t r = (size_t)(row0 + ai * 128 + m * 16);
#pragma unroll
                for (int bj = 0; bj < 2; ++bj) {
                    float gf[8], pf[8], of[8]; unpack8(gwv[m][bj], gf); unpack8(pwv[m][bj], pf);
                    const f32x4 v0 = acc[ai][bj][m][0], v1 = acc[ai][bj][m][1];
#pragma unroll
                    for (int j = 0; j < 4; ++j) { of[j] = gf[j] * v0[j] + pf[j]; of[4 + j] = gf[4 + j] * v1[j] + pf[4 + j]; }
                    *(u32x4*)(mg + r * 2048 + col0 + bj * 128) = pack8(of); } }
            asm volatile("" ::: "memory");
        }
    }
};
struct EpiRes {
    static constexpr bool PERM = false;
    const float* res; float* out;
    __device__ __forceinline__ void operator()(const f32x4 (&acc)[2][2][4][2], const pg8::Unit& u, int wr, int wc, int fr, int fq) const {
        const int row0 = u.pm * 256 + wr * 64 + fr, col0 = u.pn * 256 + wc * 32 + 4 * fq;
#pragma unroll
        for (int ai = 0; ai < 2; ++ai) {
            f32x4 r[4][2][2];
#pragma unroll
            for (int m = 0; m < 4; ++m) { const size_t off = (size_t)(row0 + ai * 128 + m * 16) * 2048 + col0;
#pragma unroll
                for (int bj = 0; bj < 2; ++bj)
#pragma unroll
                    for (int n = 0; n < 2; ++n) r[m][bj][n] = *(const f32x4*)(res + off + bj * 128 + n * 16); }
            asm volatile("" ::: "memory");
#pragma unroll
            for (int m = 0; m < 4; ++m) { const size_t off = (size_t)(row0 + ai * 128 + m * 16) * 2048 + col0;
#pragma unroll
                for (int bj = 0; bj < 2; ++bj)
#pragma unroll
                    for (int n = 0; n < 2; ++n) *(f32x4*)(out + off + bj * 128 + n * 16) = r[m][bj][n] + acc[ai][bj][m][n]; }
            asm volatile("" ::: "memory");
        }
    }
};
struct EpiRelu2 {
    static constexpr bool PERM = true;
    bf16_t* O;
    __device__ __forceinline__ void operator()(const f32x4 (&acc)[2][2][4][2], const pg8::Unit& u, int wr, int wc, int fr, int fq) const {
        const int row0 = u.pm * 256 + wr * 64 + fr, col0 = u.pn * 256 + wc * 32 + 8 * fq;
#pragma unroll
        for (int ai = 0; ai < 2; ++ai)
#pragma unroll
            for (int m = 0; m < 4; ++m) { bf16_t* rowp = O + (size_t)(row0 + ai * 128 + m * 16) * DFF + col0;
#pragma unroll
                for (int bj = 0; bj < 2; ++bj) { f32x4 v0 = acc[ai][bj][m][0], v1 = acc[ai][bj][m][1];
#pragma unroll
                    for (int j = 0; j < 4; ++j) { const float a = fmaxf(v0[j], 0.f), b = fmaxf(v1[j], 0.f); v0[j] = a * a; v1[j] = b * b; }
                    u32x4 w; w.x = cvt_pk_bf16(v0[0], v0[1]); w.y = cvt_pk_bf16(v0[2], v0[3]); w.z = cvt_pk_bf16(v1[0], v1[1]); w.w = cvt_pk_bf16(v1[2], v1[3]);
                    *(u32x4*)(rowp + bj * 128) = w; } }
    }
};

__device__ __forceinline__ void transpose_tile(const float* src, size_t ldw, bf16_t* dst, size_t ldk, float* scr, int lane) {
    f32x4 v[8];
#pragma unroll
    for (int i = 0; i < 8; ++i) v[i] = __builtin_nontemporal_load((const f32x4*)(src + (size_t)((lane >> 3) + 8 * i) * ldw + 4 * (lane & 7)));
#pragma unroll
    for (int i = 0; i < 8; ++i) *(f32x4*)(scr + ((lane >> 3) + 8 * i) * 32 + (((lane & 7) ^ i) << 2)) = v[i];
    LDS_WAIT();
    const int c = lane & 7;
#pragma unroll
    for (int j = 0; j < 4; ++j) { const int n = (lane >> 3) + 8 * j; const float* s = scr + (8 * c) * 32 + ((((n >> 2) ^ c) << 2) | (n & 3));
        u32x4 o; o.x = cvt_pk_bf16(s[0 * 32], s[1 * 32]); o.y = cvt_pk_bf16(s[2 * 32], s[3 * 32]); o.z = cvt_pk_bf16(s[4 * 32], s[5 * 32]); o.w = cvt_pk_bf16(s[6 * 32], s[7 * 32]);
        *(u32x4*)(dst + (size_t)n * ldk + 8 * c) = o; }
    LDS_WAIT();
}
__device__ __forceinline__ void transpose_item(const float* W, int K, int N, bf16_t* WT, int item, float* scr, int lane) {
    const int nblk = N / 32, kb = item / nblk, nb = item % nblk;
    transpose_tile(W + (size_t)(64 * kb) * N + 32 * nb, (size_t)N, WT + (size_t)(32 * nb) * K + 64 * kb, (size_t)K, scr, lane);
}

__device__ __forceinline__ void phase_a(KA a, int layer, const float* xin, unsigned char* lds, const int tid_, const int bid_) {
    const int tid = tid_, lane = tid & 63, wave = tid >> 6;
    const int gw = bid_ * 8 + wave, NGW = gridDim.x * 8;
    unsigned char* ws = a->ws;
    float* scr = (float*)(lds + wave * 16384);
    const float* w_in = a->in[2] + (size_t)layer * D_ * INC;
    {
        constexpr int I_IN = 32 * 320, I_OUT = 32 * 64, I_BR = 16 * 64, I_L = 64;
        constexpr int NIT = I_IN + I_OUT + 2 * I_BR + 2 * I_L;
        for (int it = gw; it < NIT; it += NGW) {
            int r = it; const float* sp; bf16_t* dp; size_t ldw, ldk;
            if (r < I_IN) { const int kb = r / 320, nb = r % 320; const int sc = 32 * nb + (nb >= 128 ? 16 : 0);
                sp = w_in + (size_t)(64 * kb) * INC + sc; ldw = INC; dp = (bf16_t*)(ws + WS_WIN_(layer)) + (size_t)(32 * nb) * D_ + 64 * kb; ldk = D_; }
            else { r -= I_IN; const float* W; bf16_t* WT; int K, N;
                if (r < I_OUT) { W = a->in[16] + (size_t)layer * D_ * D_; K = D_; N = D_; WT = (bf16_t*)(ws + WS_WOUT_(layer)); }
                else { r -= I_OUT;
                    if (r < I_BR) { W = a->in[14] + (size_t)layer * 1024 * D_; K = 1024; N = D_; WT = (bf16_t*)(ws + WS_WBG_(layer)); }
                    else { r -= I_BR;
                        if (r < I_BR) { W = a->in[15] + (size_t)layer * 1024 * D_; K = 1024; N = D_; WT = (bf16_t*)(ws + WS_WBL_(layer)); }
                        else { r -= I_BR; K = 128; N = 128;
                            if (r < I_L) { const int n = r >> 3; W = a->in[9] + (size_t)(layer * 8 + n) * 16384; WT = (bf16_t*)(ws + WS_LWA_(layer)) + n * 16384; r &= 7; }
                            else { r -= I_L; const int n = r >> 3; W = a->in[11] + (size_t)(layer * 8 + n) * 16384; WT = (bf16_t*)(ws + WS_LWX_(layer)) + n * 16384; r &= 7; } } } }
                const int nblk = N / 32, kb = r / nblk, nb = r % nblk;
                sp = W + (size_t)(64 * kb) * N + 32 * nb; ldw = N; dp = WT + (size_t)(32 * nb) * K + 64 * kb; ldk = K; }
            transpose_tile(sp, ldw, dp, ldk, scr, lane);
            asm volatile("" ::: "memory");
        }
    }
    __syncthreads();
    bf16_t* WlT = (bf16_t*)lds;
    for (int idx = tid; idx < D_ * 16; idx += 512) { const int k = idx >> 4, j = idx & 15; WlT[j * 2056 + k] = bf16_1(w_in[(size_t)k * INC + 4096 + j]); }
    __syncthreads();
    const float* gain = a->in[1] + (size_t)layer * D_;
    f32x4 gn[8];
#pragma unroll
    for (int j = 0; j < 8; ++j) gn[j] = ((const f32x4*)gain)[64 * j + lane];
    const int fr = lane & 15, fq = lane >> 4;
    const float a_log = a->in[4][layer * 8 + (fr & 7)], dtb = a->in[5][layer * 8 + (fr & 7)];
    bf16_t* H = (bf16_t*)(ws + WS_H);
    float* G = (float*)(ws + WS_G); float* BETA = (float*)(ws + WS_BETA);
    for (int grp = gw; grp < T_ / 8; grp += NGW) {
        const int row0 = grp * 8;
        for (int r8 = 0; r8 < 8; ++r8) {
            const int m = row0 + r8;
            const f32x4* xr = (const f32x4*)(xin + (size_t)m * D_) + lane;
            f32x4 v[8]; float ss = 0.f;
#pragma unroll
            for (int j = 0; j < 8; ++j) { v[j] = xr[64 * j]; ss += (v[j].x * v[j].x + v[j].y * v[j].y) + (v[j].z * v[j].z + v[j].w * v[j].w); }
            ss = wave_sum(ss);
            const float rstd = rsqrtf(ss * (1.0f / D_) + 1e-6f);
            u32x2* o8 = (u32x2*)(H + (size_t)m * D_) + lane;
#pragma unroll
            for (int j = 0; j < 8; ++j) { v[j] = v[j] * rstd * gn[j]; u32x2 w; w.x = cvt_pk_bf16(v[j].x, v[j].y); w.y = cvt_pk_bf16(v[j].z, v[j].w); o8[64 * j] = w; }
        }
        asm volatile("s_waitcnt vmcnt(0)" ::: "memory");
        f32x4 acc = (f32x4){0.f, 0.f, 0.f, 0.f};
        const bf16_t* arow = H + (size_t)(row0 + (fr & 7)) * D_ + 8 * fq;
#pragma unroll 4
        for (int kb = 0; kb < 8; ++kb) {
            bf16x8 A[8];
#pragma unroll
            for (int q = 0; q < 8; ++q) A[q] = *(const bf16x8*)(arow + 32 * (kb * 8 + q));
#pragma unroll
            for (int q = 0; q < 8; ++q) acc = __builtin_amdgcn_mfma_f32_16x16x32_bf16(A[q], *(const bf16x8*)(WlT + fr * 2056 + 32 * (kb * 8 + q) + 8 * fq), acc, 0, 0, 0);
        }
        if (fq < 2) {
#pragma unroll
            for (int j = 0; j < 4; ++j) { const int m = row0 + 4 * fq + j;
                if (fr < 8) G[(size_t)m * 8 + fr] = -expf(a_log) * softplusf_(acc[j] + dtb);
                else BETA[(size_t)m * 8 + (fr - 8)] = sigmoidf_(acc[j]); }
        }
    }
}

__device__ __forceinline__ void phase_g(KA a, int layer, const float* x1, unsigned char* lds, const int tid_, const int bid_) {
    const int tid = tid_, lane = tid & 63, wave = tid >> 6;
    const int gw = bid_ * 8 + wave, NGW = gridDim.x * 8;
    unsigned char* ws = a->ws;
    float* scr = (float*)(lds + wave * 16384);
    for (int it = gw; it < 16384; it += NGW) {
        const bool up = it < 8192; const int r = up ? it : it - 8192;
        const float* W = up ? a->in[18] + (size_t)layer * D_ * DFF : a->in[19] + (size_t)layer * DFF * D_;
        bf16_t* WT = (bf16_t*)(ws + (up ? WS_WUP : WS_WDN)); const int K = up ? D_ : DFF, N = up ? DFF : D_;
        const int nblk = N / 32, kb = r / nblk, nb = r % nblk;
        transpose_tile(W + (size_t)(64 * kb) * N + 32 * nb, (size_t)N, WT + (size_t)(32 * nb) * K + 64 * kb, (size_t)K, scr, lane);
        asm volatile("" ::: "memory");
    }
    const float* gain = a->in[17] + (size_t)layer * D_;
    f32x4 gn[8];
#pragma unroll
    for (int j = 0; j < 8; ++j) gn[j] = ((const f32x4*)gain)[64 * j + lane];
    bf16_t* H = (bf16_t*)(ws + WS_H);
    for (int m = gw; m < T_; m += NGW) {
        const f32x4* xr = (const f32x4*)(x1 + (size_t)m * D_) + lane;
        f32x4 v[8]; float ss = 0.f;
#pragma unroll
        for (int j = 0; j < 8; ++j) { v[j] = xr[64 * j]; ss += (v[j].x * v[j].x + v[j].y * v[j].y) + (v[j].z * v[j].z + v[j].w * v[j].w); }
        ss = wave_sum(ss);
        const float rstd = rsqrtf(ss * (1.0f / D_) + 1e-6f);
        u32x2* o8 = (u32x2*)(H + (size_t)m * D_) + lane;
#pragma unroll
        for (int j = 0; j < 8; ++j) { v[j] = v[j] * rstd * gn[j]; u32x2 w; w.x = cvt_pk_bf16(v[j].x, v[j].y); w.y = cvt_pk_bf16(v[j].z, v[j].w); o8[64 * j] = w; }
    }
}
__device__ __forceinline__ void phase_final(KA a, const float* x, const int tid_, const int bid_) {
    const int tid = tid_, lane = tid & 63, wave = tid >> 6;
    const int gw = bid_ * 8 + wave, NGW = gridDim.x * 8;
    const float* gain = a->in[20];
    f32x4 gn[8];
#pragma unroll
    for (int j = 0; j < 8; ++j) gn[j] = ((const f32x4*)gain)[64 * j + lane];
    for (int m = gw; m < T_; m += NGW) {
        const f32x4* xr = (const f32x4*)(x + (size_t)m * D_) + lane;
        f32x4 v[8]; float ss = 0.f;
#pragma unroll
        for (int j = 0; j < 8; ++j) { v[j] = xr[64 * j]; ss += (v[j].x * v[j].x + v[j].y * v[j].y) + (v[j].z * v[j].z + v[j].w * v[j].w); }
        ss = wave_sum(ss);
        const float rstd = rsqrtf(ss * (1.0f / D_) + 1e-6f);
        f32x4* o = (f32x4*)(a->out + (size_t)m * D_) + lane;
#pragma unroll
        for (int j = 0; j < 8; ++j) o[64 * j] = v[j] * rstd * gn[j];
    }
}

__device__ __forceinline__ void gdn_prep(KA a, int layer, unsigned char* lds, const int tid_, const int bid_) {
    const int tid = tid_, lane = tid & 63, wave = tid >> 6, tl = tid >> 3, sub = tid & 7;
    unsigned char* ws = a->ws;
    const float* cw = a->in[3] + (size_t)layer * 4 * 3072;
    const bf16_t* QKV = (const bf16_t*)(ws + WS_QKV);
    const float* G = (const float*)(ws + WS_G); const float* BETA = (const float*)(ws + WS_BETA);
    unsigned char* Kb = lds; unsigned char* Qb = lds + 17408; float* Ls = (float*)(lds + 34816); float* RHS = (float*)(lds + 52224);
    float* gcs = (float*)(lds + 118784); float* bts = gcs + 64; unsigned char* QKs = lds + 119296; unsigned char* KDTs = lds;
    float* cwl = (float*)(lds + 128512);
    int h_loaded = -1;
    float g_nx = 0.f, b_nx = 0.f;
    if (wave == 0 && bid_ < 2048) { g_nx = G[(size_t)((bid_ >> 3) * 64 + lane) * 8 + (bid_ & 7)]; b_nx = BETA[(size_t)((bid_ >> 3) * 64 + lane) * 8 + (bid_ & 7)]; }
    for (int item = bid_; item < 2048; item += gridDim.x) {
        const int c = item >> 3, h = item & 7, tg0 = c * 64;
        const int tg = tg0 + tl, s = tg & (SEQ_ - 1);
        if (h != h_loaded) {
            if (tid < 384) { const int pj = tid >> 5, q4 = tid & 31; *(f32x4*)(cwl + pj * 128 + q4 * 4) = *(const f32x4*)(cw + (pj & 3) * 3072 + (pj >> 2) * 1024 + h * 128 + q4 * 4); }
            h_loaded = h;
            __syncthreads();
        }
        u32x4 xr[2][4][2];
#define PREP_LOAD(p) do { _Pragma("unroll") for (int j = 0; j < 4; ++j) { const int rowi = (s - 3 + j >= 0) ? tg - 3 + j : tg; const bf16_t* row = QKV + (size_t)rowi * 3072 + (p) * 1024 + h * 128 + 16 * sub; \
                xr[(p) & 1][j][0] = *(const u32x4*)row; xr[(p) & 1][j][1] = *(const u32x4*)(row + 8); } } while (0)
        PREP_LOAD(0); PREP_LOAD(1);
        if (wave == 0) {
            float g = g_nx; const float bt = b_nx;
            const int nit = item + gridDim.x;
            if (nit < 2048) { g_nx = G[(size_t)((nit >> 3) * 64 + lane) * 8 + (nit & 7)]; b_nx = BETA[(size_t)((nit >> 3) * 64 + lane) * 8 + (nit & 7)]; }
#pragma unroll
            for (int o = 1; o < 64; o <<= 1) { const float t = __shfl_up(g, o); if (lane >= o) g += t; }
            gcs[lane] = g; bts[lane] = bt;
            if (lane == 63) ((float*)(ws + WS_EGL))[item] = expf(g);
        }
        float qkv[3][16];
#pragma unroll
        for (int p = 0; p < 3; ++p) {
#pragma unroll
            for (int e = 0; e < 16; ++e) qkv[p][e] = 0.f;
#pragma unroll
            for (int j = 0; j < 4; ++j) {
                const float vm = (s - 3 + j >= 0) ? 1.0f : 0.0f;
                float x[16]; unpack8(xr[p & 1][j][0], x); unpack8(xr[p & 1][j][1], x + 8);
                const f32x4* wp = (const f32x4*)(cwl + (p * 4 + j) * 128 + 16 * sub);
#pragma unroll
                for (int q = 0; q < 4; ++q) { const f32x4 w4 = wp[q] * vm; qkv[p][4 * q] += w4.x * x[4 * q]; qkv[p][4 * q + 1] += w4.y * x[4 * q + 1]; qkv[p][4 * q + 2] += w4.z * x[4 * q + 2]; qkv[p][4 * q + 3] += w4.w * x[4 * q + 3]; }
            }
            if (p == 0) { asm volatile("" ::: "memory"); PREP_LOAD(2); }
#pragma unroll
            for (int e = 0; e < 16; ++e) qkv[p][e] = siluf_(qkv[p][e]);
            if (p < 2) {
                float ss = 0.f;
#pragma unroll
                for (int e = 0; e < 16; ++e) ss += qkv[p][e] * qkv[p][e];
                ss += __shfl_xor(ss, 1); ss += __shfl_xor(ss, 2); ss += __shfl_xor(ss, 4);
                const float sc = rsqrtf(ss + 1e-6f) * (p == 0 ? 0.08838834764831845f : 1.0f);
#pragma unroll
                for (int e = 0; e < 16; ++e) qkv[p][e] *= sc;
            }
        }
        __syncthreads();
        const float gci = gcs[tl], gl = gcs[63], bi = bts[tl];
        const float eg = __expf(gci), ekd = __expf(gl - gci);
        *(u32x4*)(Kb + tl * 272 + sub * 32) = pack8(qkv[1]); *(u32x4*)(Kb + tl * 272 + sub * 32 + 16) = pack8(qkv[1] + 8);
        *(u32x4*)(Qb + tl * 272 + sub * 32) = pack8(qkv[0]); *(u32x4*)(Qb + tl * 272 + sub * 32 + 16) = pack8(qkv[0] + 8);
#pragma unroll
        for (int q = 0; q < 4; ++q) {
            *(f32x4*)(RHS + tl * 260 + 16 * sub + 4 * q) = (f32x4){bi * qkv[2][4 * q], bi * qkv[2][4 * q + 1], bi * qkv[2][4 * q + 2], bi * qkv[2][4 * q + 3]};
            const float bk = bi * eg;
            *(f32x4*)(RHS + tl * 260 + 128 + 16 * sub + 4 * q) = (f32x4){bk * qkv[1][4 * q], bk * qkv[1][4 * q + 1], bk * qkv[1][4 * q + 2], bk * qkv[1][4 * q + 3]};
        }
        {
            float qd[16];
#pragma unroll
            for (int e = 0; e < 16; ++e) { qd[e] = qkv[0][e] * eg; qkv[1][e] *= ekd; }
            bf16_t* dst = (bf16_t*)(ws + WS_QD) + (size_t)tg * 1024 + h * 128 + 16 * sub;
            *(u32x4*)dst = pack8(qd); *(u32x4*)(dst + 8) = pack8(qd + 8);
        }
        __syncthreads();
        {
            const int fr = lane & 15, fq = lane >> 4, ti = wave >> 1, tj0 = (wave & 1) * 2;
            bf16x8 Ak[4], Aq[4];
#pragma unroll
            for (int ks = 0; ks < 4; ++ks) { Ak[ks] = *(const bf16x8*)(Kb + (16 * ti + fr) * 272 + (32 * ks + 8 * fq) * 2); Aq[ks] = *(const bf16x8*)(Qb + (16 * ti + fr) * 272 + (32 * ks + 8 * fq) * 2); }
#pragma unroll
            for (int jj = 0; jj < 2; ++jj) {
                const int tj = tj0 + jj;
                f32x4 ckk = (f32x4){0.f, 0.f, 0.f, 0.f}, cqk = (f32x4){0.f, 0.f, 0.f, 0.f};
#pragma unroll
                for (int ks = 0; ks < 4; ++ks) { const bf16x8 B = *(const bf16x8*)(Kb + (16 * tj + fr) * 272 + (32 * ks + 8 * fq) * 2);
                    ckk = __builtin_amdgcn_mfma_f32_16x16x32_bf16(Ak[ks], B, ckk, 0, 0, 0); cqk = __builtin_amdgcn_mfma_f32_16x16x32_bf16(Aq[ks], B, cqk, 0, 0, 0); }
                const int jc = 16 * tj + fr; const float gj = gcs[jc];
#pragma unroll
                for (int j = 0; j < 4; ++j) { const int i = 16 * ti + 4 * fq + j; const float gi = gcs[i], bti = bts[i];
                    const float e = __expf(i >= jc ? gi - gj : 0.f);
                    Ls[i * 68 + jc] = (i > jc) ? bti * ckk[j] * e : 0.f;
                    ((bf16_t*)QKs)[i * 72 + jc] = bf16_1((i >= jc) ? cqk[j] * e : 0.f); }
            }
        }
        __syncthreads();
#pragma unroll
        for (int e = 0; e < 16; ++e) ((bf16_t*)KDTs)[(16 * sub + e) * 72 + ((((tl >> 3) ^ sub) << 3) | (tl & 7))] = bf16_1(qkv[1][e]);
        if (tid < 256) {
            float x[64];
#pragma unroll
            for (int i = 0; i < 64; ++i) x[i] = RHS[i * 260 + tid];
            f32x4 bufA[8], bufB[8];
#define SUB_LROW(buf, i_, j0_, n_) do { _Pragma("unroll") for (int j4 = 0; j4 < (n_); ++j4) buf[j4] = *(const f32x4*)(Ls + (i_) * 68 + 4 * ((j0_) + j4)); } while (0)
#define SUB_FROW(buf, j0_, n_) do { _Pragma("unroll") for (int j4 = 0; j4 < (n_); ++j4) { const f32x4 l = buf[j4]; \
                acc -= l.x * x[4 * ((j0_) + j4)]; acc -= l.y * x[4 * ((j0_) + j4) + 1]; acc -= l.z * x[4 * ((j0_) + j4) + 2]; acc -= l.w * x[4 * ((j0_) + j4) + 3]; } } while (0)
#pragma unroll
            for (int j4 = 0; j4 < 8; ++j4) { bufA[j4] = (f32x4){0.f, 0.f, 0.f, 0.f}; bufB[j4] = (f32x4){0.f, 0.f, 0.f, 0.f}; }
            SUB_LROW(bufA, 1, 0, 1);
#pragma unroll
            for (int i = 1; i <= 32; ++i) {
                const int nn = (i + 4) / 4 < 8 ? (i + 4) / 4 : 8;
                float acc = x[i];
                if (i & 1) { SUB_LROW(bufB, i + 1, 0, nn); __builtin_amdgcn_sched_barrier(0); SUB_FROW(bufA, 0, (i + 3) / 4); }
                else       { SUB_LROW(bufA, i + 1, 0, nn); __builtin_amdgcn_sched_barrier(0); SUB_FROW(bufB, 0, (i + 3) / 4); }
                x[i] = acc;
                __builtin_amdgcn_sched_barrier(0);
            }
#pragma unroll
            for (int i = 33; i < 64; ++i) {
                float acc = x[i];
                SUB_LROW(bufB, i, 8, (i + 3) / 4 - 8); __builtin_amdgcn_sched_barrier(0);
                SUB_FROW(bufA, 0, 8); __builtin_amdgcn_sched_barrier(0);
                if (i + 1 < 64) SUB_LROW(bufA, i + 1, 0, 8);
                __builtin_amdgcn_sched_barrier(0);
                SUB_FROW(bufB, 8, (i + 3) / 4 - 8);
                x[i] = acc;
                __builtin_amdgcn_sched_barrier(0);
            }
#undef SUB_LROW
#undef SUB_FROW
#pragma unroll
            for (int i = 0; i < 64; ++i) RHS[i * 260 + tid] = x[i];
        } else {
            const int t2 = tid - 256;
#pragma unroll
            for (int r = 0; r < 2; ++r) { const int idx = t2 + 256 * r; *(u32x4*)((bf16_t*)(ws + WS_QK) + (size_t)item * 4096 + idx * 8) = *(const u32x4*)(QKs + (idx >> 3) * 144 + (idx & 7) * 16); }
        }
        __syncthreads();
        {
            float xu[16], xw[16];
#pragma unroll
            for (int q = 0; q < 4; ++q) { const f32x4 u4 = *(const f32x4*)(RHS + tl * 260 + 16 * sub + 4 * q), w4 = *(const f32x4*)(RHS + tl * 260 + 128 + 16 * sub + 4 * q);
                xu[4 * q] = u4.x; xu[4 * q + 1] = u4.y; xu[4 * q + 2] = u4.z; xu[4 * q + 3] = u4.w; xw[4 * q] = w4.x; xw[4 * q + 1] = w4.y; xw[4 * q + 2] = w4.z; xw[4 * q + 3] = w4.w; }
            bf16_t* du = (bf16_t*)(ws + WS_U) + (size_t)tg * 1024 + h * 128 + 16 * sub; bf16_t* dw = (bf16_t*)(ws + WS_W) + (size_t)tg * 1024 + h * 128 + 16 * sub;
            *(u32x4*)du = pack8(xu); *(u32x4*)(du + 8) = pack8(xu + 8); *(u32x4*)dw = pack8(xw); *(u32x4*)(dw + 8) = pack8(xw + 8);
#pragma unroll
            for (int r = 0; r < 2; ++r) { const int idx = tid + 512 * r; *(u32x4*)((bf16_t*)(ws + WS_KDT) + (size_t)item * 8192 + idx * 8) = *(const u32x4*)(KDTs + (idx >> 3) * 144 + (((idx & 7) ^ ((idx >> 7) & 7)) * 16)); }
        }
        __syncthreads();
    }
}

__device__ __forceinline__ void gdn_scan(KA a, int layer, unsigned char* lds, const int tid_, const int bid_) {
    const int tid = tid_, lane = tid & 63, wave = __builtin_amdgcn_readfirstlane(tid >> 6), fr = lane & 15, fq = lane >> 4;
    unsigned char* ws = a->ws;
    for (int wi = bid_; wi < 256; wi += gridDim.x) {
    const int q = wi >> 3, bh = (wi & 7) * 4 + (q & 3), slice = q >> 2, b = bh >> 3, h = bh & 7;
    unsigned char* Wl = lds; unsigned char* QDl = lds + 17408; unsigned char* KDTl = lds + 34816; unsigned char* QKl = lds + 53248;
    unsigned char* Ul = lds + 62464; unsigned char* SlT = lds + 64512; unsigned char* VNT = lds + 68864;
    const bf16_t* Wg = (const bf16_t*)(ws + WS_W); const bf16_t* QDg = (const bf16_t*)(ws + WS_QD); const bf16_t* Ug = (const bf16_t*)(ws + WS_U);
    const bf16_t* KDTg = (const bf16_t*)(ws + WS_KDT); const bf16_t* QKg = (const bf16_t*)(ws + WS_QK); const float* EGL = (const float*)(ws + WS_EGL);
    bf16_t* ORAW = (bf16_t*)(ws + WS_ORAW);
    const int i = wave & 3; const bool isQ = wave >= 4;
    const unsigned char* abase = isQ ? QDl : Wl;
    f32x4 S = (f32x4){0.f, 0.f, 0.f, 0.f}, out = (f32x4){0.f, 0.f, 0.f, 0.f};
    u32x4 rW[2], rQD[2], rK[2], rQK, rU; float egl_cur, egl_next = 0.f;
    rU = (u32x4){0u, 0u, 0u, 0u};
#define GS_LOAD_A(n) do { const int tg0_ = b * SEQ_ + (n) * 64; \
        _Pragma("unroll") for (int r = 0; r < 2; ++r) { const int idx = tid + 512 * r; const size_t off = (size_t)(tg0_ + (idx >> 4)) * 1024 + h * 128 + (idx & 15) * 8; \
            rW[r] = *(const u32x4*)(Wg + off); rQD[r] = *(const u32x4*)(QDg + off); } \
        if (tid < 128) rU = *(const u32x4*)(Ug + (size_t)(tg0_ + (tid >> 1)) * 1024 + h * 128 + slice * 16 + (tid & 1) * 8); } while (0)
#define GS_STORE_A() do { _Pragma("unroll") for (int r = 0; r < 2; ++r) { const int idx = tid + 512 * r; const int o1 = (idx >> 4) * 272 + (idx & 15) * 16; \
            *(u32x4*)(Wl + o1) = rW[r]; *(u32x4*)(QDl + o1) = rQD[r]; } \
        if (tid < 128) *(u32x4*)(Ul + (tid >> 1) * 32 + (tid & 1) * 16) = rU; } while (0)
#define GS_LOAD_B(n) do { const int item_ = ((b * 64 + (n)) * 8 + h); \
        _Pragma("unroll") for (int r = 0; r < 2; ++r) { const int idx = tid + 512 * r; rK[r] = *(const u32x4*)(KDTg + (size_t)item_ * 8192 + idx * 8); } \
        rQK = *(const u32x4*)(QKg + (size_t)item_ * 4096 + tid * 8); egl_next = EGL[item_]; } while (0)
#define GS_STORE_B() do { _Pragma("unroll") for (int r = 0; r < 2; ++r) { const int idx = tid + 512 * r; *(u32x4*)(KDTl + (idx >> 3) * 144 + (idx & 7) * 16) = rK[r]; } \
        *(u32x4*)(QKl + (tid >> 3) * 144 + (tid & 7) * 16) = rQK; } while (0)
    GS_LOAD_A(0); GS_LOAD_B(0); GS_STORE_A(); GS_STORE_B(); egl_cur = egl_next;
    if (tid < 272) *(u32x4*)(SlT + tid * 16) = (u32x4){0u, 0u, 0u, 0u};
    GS_LOAD_A(1);
    __syncthreads();
    for (int n = 0; n < 64; ++n) {
        const int tg0 = b * SEQ_ + n * 64;
        {
            f32x4 acc = (f32x4){0.f, 0.f, 0.f, 0.f};
#pragma unroll
            for (int ks = 0; ks < 4; ++ks)
                acc = __builtin_amdgcn_mfma_f32_16x16x32_bf16(*(const bf16x8*)(abase + (16 * i + fr) * 272 + (32 * ks + 8 * fq) * 2), *(const bf16x8*)(SlT + fr * 272 + (32 * ks + 8 * fq) * 2), acc, 0, 0, 0);
            if (!isQ) {
                float vn[4];
#pragma unroll
                for (int j = 0; j < 4; ++j) { const float u = __uint_as_float(((unsigned)*(const bf16_t*)(Ul + (16 * i + 4 * fq + j) * 32 + fr * 2)) << 16); vn[j] = u - acc[j]; }
                u32x2 w; w.x = cvt_pk_bf16(vn[0], vn[1]); w.y = cvt_pk_bf16(vn[2], vn[3]);
                *(u32x2*)(VNT + fr * 144 + (16 * i + 4 * fq) * 2) = w;
            } else out = acc;
        }
        if (n > 0) { GS_STORE_B(); egl_cur = egl_next; }
        if (n + 1 < 64) GS_LOAD_B(n + 1);
        __syncthreads();
        {
            bf16x8 Bv[2];
#pragma unroll
            for (int ks = 0; ks < 2; ++ks) Bv[ks] = *(const bf16x8*)(VNT + fr * 144 + (32 * ks + 8 * fq) * 2);
            f32x4 accS = S * egl_cur;
#pragma unroll
            for (int ks = 0; ks < 2; ++ks) accS = __builtin_amdgcn_mfma_f32_16x16x32_bf16(*(const bf16x8*)(KDTl + (16 * wave + fr) * 144 + (32 * ks + 8 * fq) * 2), Bv[ks], accS, 0, 0, 0);
            S = accS;
            { u32x2 w; w.x = cvt_pk_bf16(S[0], S[1]); w.y = cvt_pk_bf16(S[2], S[3]); *(u32x2*)(SlT + fr * 272 + (16 * wave + 4 * fq) * 2) = w; }
            if (isQ) {
#pragma unroll
                for (int ks = 0; ks < 2; ++ks) out = __builtin_amdgcn_mfma_f32_16x16x32_bf16(*(const bf16x8*)(QKl + (16 * i + fr) * 144 + (32 * ks + 8 * fq) * 2), Bv[ks], out, 0, 0, 0);
#pragma unroll
                for (int j = 0; j < 4; ++j) ORAW[(size_t)(tg0 + 16 * i + 4 * fq + j) * 1024 + h * 128 + 16 * slice + fr] = bf16_1(out[j]);
            }
        }
        if (n + 1 < 64) { GS_STORE_A(); if (n + 2 < 64) GS_LOAD_A(n + 2); }
        __syncthreads();
    }
    __syncthreads();
    }
#undef GS_LOAD_A
#undef GS_STORE_A
#undef GS_LOAD_B
#undef GS_STORE_B
}
__device__ __forceinline__ void gdn_norm(KA a, int layer, const int tid_, const int bid_) {
    const int tid = tid_, tl = tid >> 3, sub = tid & 7;
    unsigned char* ws = a->ws;
    const float* ng = a->in[6] + layer * 128 + 16 * sub;
    for (int item = bid_; item < 2048; item += gridDim.x) {
        const int c = item >> 3, h = item & 7;
        const size_t go = (size_t)(c * 64 + tl) * 1024 + h * 128 + 16 * sub;
        float o[16], zf[16]; float ms = 0.f;
        { const u32x4 o0 = *(const u32x4*)((const bf16_t*)(ws + WS_ORAW) + go), o1 = *(const u32x4*)((const bf16_t*)(ws + WS_ORAW) + go + 8); unpack8(o0, o); unpack8(o1, o + 8); }
#pragma unroll
        for (int e = 0; e < 16; ++e) ms += o[e] * o[e];
        ms += __shfl_xor(ms, 1); ms += __shfl_xor(ms, 2); ms += __shfl_xor(ms, 4);
        const float r = rsqrtf(ms * (1.0f / 128.0f) + 1e-6f);
        { const u32x4 z0 = *(const u32x4*)((const bf16_t*)(ws + WS_Z) + go), z1 = *(const u32x4*)((const bf16_t*)(ws + WS_Z) + go + 8); unpack8(z0, zf); unpack8(z1, zf + 8); }
#pragma unroll
        for (int e = 0; e < 16; ++e) o[e] = o[e] * r * ng[e] * siluf_(zf[e]);
        bf16_t* dst = (bf16_t*)(ws + WS_OG) + go;
        *(u32x4*)dst = pack8(o); *(u32x4*)(dst + 8) = pack8(o + 8);
    }
}

template <bool P3>
__device__ __forceinline__ void lru_pass(KA a, int layer, unsigned char* lds, const int tid_, const int bid_) {
    const int tid = tid_, lane = tid & 63, wave = tid >> 6, tl = tid >> 3, sub = tid & 7, fr = lane & 15, fq = lane >> 4;
    unsigned char* ws = a->ws;
    float* XCF = (float*)lds; float* AL = XCF + 8448; bf16_t* XCB = (bf16_t*)(AL + 8448); float* CP = (float*)((unsigned char*)XCB + 17408);
    float* lcw = CP + 1024;
    float* SEG = lcw + 640;
    const bf16_t* XB = (const bf16_t*)(ws + WS_XB);
    float* AGGA = (float*)(ws + WS_AGGA); float* AGGB = (float*)(ws + WS_AGGB);
    int n_loaded = -1;
    bf16x8 Ba[4], Bx[4]; float ba = 0.f, bx = 0.f, spl = 0.f;
#pragma unroll
    for (int ks = 0; ks < 4; ++ks) { Ba[ks] = (bf16x8){0, 0, 0, 0, 0, 0, 0, 0}; Bx[ks] = (bf16x8){0, 0, 0, 0, 0, 0, 0, 0}; }
    for (int item = bid_; item < 2048; item += gridDim.x) {
        const int c = item >> 3, n = item & 7;
        const int tg = c * 64 + tl, s = tg & (SEQ_ - 1), ch0 = n * 128 + 16 * sub;
        u32x4 xr[4][2];
#pragma unroll
        for (int j = 0; j < 4; ++j) { const int rowi = (s - 3 + j >= 0) ? tg - 3 + j : tg; const bf16_t* row = XB + (size_t)rowi * 1024 + ch0; xr[j][0] = *(const u32x4*)row; xr[j][1] = *(const u32x4*)(row + 8); }
        u32x4 yr0 = (u32x4){0u, 0u, 0u, 0u}, yr1 = yr0;
        u32x4 go0 = yr0, go1 = yr0, gz0 = yr0, gz1 = yr0;
        float Ap = 1.f, Bp = 0.f;
        if (P3) {
            { const size_t gq = (size_t)tg * 1024 + ch0; const bf16_t* op = (const bf16_t*)(ws + WS_ORAW) + gq; const bf16_t* zp = (const bf16_t*)(ws + WS_Z) + gq;
              go0 = *(const u32x4*)op; go1 = *(const u32x4*)(op + 8); gz0 = *(const u32x4*)zp; gz1 = *(const u32x4*)(zp + 8); }
            const bf16_t* yrow = (const bf16_t*)(ws + WS_YB) + (size_t)tg * 1024 + ch0; yr0 = *(const u32x4*)yrow; yr1 = *(const u32x4*)(yrow + 8);
            const int chl = tid & 127, part = tid >> 7; const int cb0 = (c & ~63) + part * 16;
            float av[16], bv[16];
#pragma unroll
            for (int i = 0; i < 16; ++i) { const int cc = cb0 + i; const int ci = cc < c ? cc : c; av[i] = AGGA[(size_t)ci * 1024 + n * 128 + chl]; bv[i] = AGGB[(size_t)ci * 1024 + n * 128 + chl]; }
#pragma unroll
            for (int i = 0; i < 16; ++i) { if (cb0 + i < c) { Bp = av[i] * Bp + bv[i]; Ap = av[i] * Ap; } }
        }
        if (n != n_loaded) {
            if (tid < 160) { const int j = tid >> 5, q4 = tid & 31; *(f32x4*)(lcw + j * 128 + q4 * 4) = (j < 4) ? *(const f32x4*)(a->in[7] + (size_t)(layer * 4 + j) * 1024 + n * 128 + q4 * 4) : *(const f32x4*)(a->in[8] + layer * 1024 + n * 128 + q4 * 4); }
            const bf16_t* wa = (const bf16_t*)(ws + WS_LWA_(layer)) + (size_t)(n * 128 + 16 * wave + fr) * 128 + fq * 8;
            const bf16_t* wx = (const bf16_t*)(ws + WS_LWX_(layer)) + (size_t)(n * 128 + 16 * wave + fr) * 128 + fq * 8;
#pragma unroll
            for (int ks = 0; ks < 4; ++ks) { Ba[ks] = *(const bf16x8*)(wa + ks * 32); Bx[ks] = *(const bf16x8*)(wx + ks * 32); }
            const int ch = n * 128 + 16 * wave + fr;
            ba = a->in[10][layer * 1024 + ch]; bx = a->in[12][layer * 1024 + ch]; spl = softplusf_(-a->in[13][layer * 1024 + ch]);
            n_loaded = n;
            __syncthreads();
        }
        {
            float xc[16];
#pragma unroll
            for (int q = 0; q < 4; ++q) { const f32x4 b4 = *(const f32x4*)(lcw + 4 * 128 + 16 * sub + 4 * q); xc[4 * q] = b4.x; xc[4 * q + 1] = b4.y; xc[4 * q + 2] = b4.z; xc[4 * q + 3] = b4.w; }
#pragma unroll
            for (int j = 0; j < 4; ++j) {
                const float vm = (s - 3 + j >= 0) ? 1.0f : 0.0f;
                float x[16]; unpack8(xr[j][0], x); unpack8(xr[j][1], x + 8);
#pragma unroll
                for (int q = 0; q < 4; ++q) { const f32x4 w4 = *(const f32x4*)(lcw + j * 128 + 16 * sub + 4 * q) * vm; xc[4 * q] += w4.x * x[4 * q]; xc[4 * q + 1] += w4.y * x[4 * q + 1]; xc[4 * q + 2] += w4.z * x[4 * q + 2]; xc[4 * q + 3] += w4.w * x[4 * q + 3]; }
            }
#pragma unroll
            for (int q = 0; q < 4; ++q) *(f32x4*)(XCF + tl * 132 + 16 * sub + 4 * q) = (f32x4){xc[4 * q], xc[4 * q + 1], xc[4 * q + 2], xc[4 * q + 3]};
            *(u32x4*)(XCB + tl * 136 + 16 * sub) = pack8(xc); *(u32x4*)(XCB + tl * 136 + 16 * sub + 8) = pack8(xc + 8);
            if (P3) { CP[((tid >> 7) * 128 + (tid & 127)) * 2] = Ap; CP[((tid >> 7) * 128 + (tid & 127)) * 2 + 1] = Bp; }
        }
        __syncthreads();
        {
            f32x4 accA[4], accX[4];
#pragma unroll
            for (int tile = 0; tile < 4; ++tile) { accA[tile] = (f32x4){0.f, 0.f, 0.f, 0.f}; accX[tile] = (f32x4){0.f, 0.f, 0.f, 0.f};
#pragma unroll
                for (int ks = 0; ks < 4; ++ks) { const bf16x8 A = *(const bf16x8*)(XCB + (tile * 16 + fr) * 136 + ks * 32 + fq * 8);
                    accA[tile] = __builtin_amdgcn_mfma_f32_16x16x32_bf16(A, Ba[ks], accA[tile], 0, 0, 0);
                    accX[tile] = __builtin_amdgcn_mfma_f32_16x16x32_bf16(A, Bx[ks], accX[tile], 0, 0, 0); } }
            const int chl = 16 * wave + fr;
#pragma unroll
            for (int tile = 0; tile < 4; ++tile)
#pragma unroll
                for (int j = 0; j < 4; ++j) { const int tok = tile * 16 + fq * 4 + j;
                    const float r = sigmoidf_(accA[tile][j] + ba), ig = sigmoidf_(accX[tile][j] + bx);
                    const float la = -8.0f * r * spl; const float av = __expf(la);
                    const float bt = __builtin_sqrtf(fmaxf(1.0f - av * av, 0.f)) * ig * XCF[tok * 132 + chl];
                    AL[tok * 132 + chl] = av; XCF[tok * 132 + chl] = bt; }
        }
        __syncthreads();
        {
            const int chl = tid & 127, seg = tid >> 7, t0 = seg * 16;
            float av[16], bv[16];
#pragma unroll
            for (int t = 0; t < 16; ++t) { av[t] = AL[(t0 + t) * 132 + chl]; bv[t] = XCF[(t0 + t) * 132 + chl]; }
            float hl = 0.f, Pl = 1.f;
#pragma unroll
            for (int t = 0; t < 16; ++t) { hl = av[t] * hl + bv[t]; Pl *= av[t]; }
            SEG[(seg * 128 + chl) * 2] = Pl; SEG[(seg * 128 + chl) * 2 + 1] = hl;
            __syncthreads();
            if (P3) {
                float h = 0.f;
#pragma unroll
                for (int part = 0; part < 4; ++part) h = CP[(part * 128 + chl) * 2] * h + CP[(part * 128 + chl) * 2 + 1];
#pragma unroll
                for (int s2 = 0; s2 < 3; ++s2) { if (s2 < seg) h = SEG[(s2 * 128 + chl) * 2] * h + SEG[(s2 * 128 + chl) * 2 + 1]; }
#pragma unroll
                for (int t = 0; t < 16; ++t) { h = av[t] * h + bv[t]; XCF[(t0 + t) * 132 + chl] = h; }
            } else if (tid < 128) {
                float h = 0.f, P = 1.f;
#pragma unroll
                for (int s2 = 0; s2 < 4; ++s2) { const float Ps = SEG[(s2 * 128 + tid) * 2], hs = SEG[(s2 * 128 + tid) * 2 + 1]; h = Ps * h + hs; P *= Ps; }
                AGGA[(size_t)c * 1024 + n * 128 + tid] = P; AGGB[(size_t)c * 1024 + n * 128 + tid] = h;
            }
        }
        __syncthreads();
        if (P3) {
            float y[16], o[16]; unpack8(yr0, y); unpack8(yr1, y + 8);
#pragma unroll
            for (int e = 0; e < 16; ++e) o[e] = XCF[tl * 132 + 16 * sub + e] * gelu_tanh(y[e]);
            bf16_t* dst = (bf16_t*)(ws + WS_OL) + (size_t)tg * 1024 + ch0;
            *(u32x4*)dst = pack8(o); *(u32x4*)(dst + 8) = pack8(o + 8);
            {
                float go[16], zf[16]; unpack8(go0, go); unpack8(go1, go + 8); unpack8(gz0, zf); unpack8(gz1, zf + 8);
                float ms = 0.f;
#pragma unroll
                for (int e = 0; e < 16; ++e) ms += go[e] * go[e];
                ms += __shfl_xor(ms, 1); ms += __shfl_xor(ms, 2); ms += __shfl_xor(ms, 4);
                const float rn = rsqrtf(ms * (1.0f / 128.0f) + 1e-6f);
                const float* ngp = a->in[6] + layer * 128 + 16 * sub;
#pragma unroll
                for (int e = 0; e < 16; ++e) go[e] = go[e] * rn * ngp[e] * siluf_(zf[e]);
                bf16_t* gd = (bf16_t*)(ws + WS_OG) + (size_t)tg * 1024 + ch0;
                *(u32x4*)gd = pack8(go); *(u32x4*)(gd + 8) = pack8(go + 8);
            }
            __syncthreads();
        }
    }
}

constexpr int NPH = 21;
__global__ void __launch_bounds__(512, 2) mega(Args a_) {
    extern __shared__ __attribute__((aligned(16))) unsigned char lds[];
    LAS unsigned char* lds3 = (LAS unsigned char*)lds;
    KA ap = (KA)__builtin_amdgcn_kernarg_segment_ptr();
    const int ph_hi = ap->ph_hi;
    volatile LAS unsigned* xb_st = (volatile LAS unsigned*)(lds3 + (LDS_BYTES - 16));
    if (threadIdx.x == 0) { xb_st[0] = 0u; xb_st[1] = 0u; }
    __syncthreads();
    XcdBarrier xbar = xcd_barrier_post((unsigned*)(ap->ws + WS_CTL) + 64, xb_st);
    for (int ph = ap->ph_lo; ph < ph_hi; ++ph) {
        const int layer = ph / 10, k = ph % 10;
        KA a = ap; asm volatile("" : "+s"(a));
        int tid = threadIdx.x; asm volatile("" : "+v"(tid));
        int bid = blockIdx.x; asm volatile("" : "+s"(bid));
        unsigned char* ws = a->ws;
        const float* xin = layer == 0 ? a->in[0] : a->out;
        if (ph == 20) { if (PHMASK & 512) phase_final(a, a->out, tid, bid); }
        else if (k == 0) { for (int rp = 0; rp < NREP(6); ++rp) { phase_a(a, layer, xin, lds, tid, bid); __syncthreads(); } }
        else if (k == 1) { if (PHMASK & 2) {
            pg8::Gemm g{(const bf16_t*)(ws + WS_H), (const bf16_t*)(ws + WS_WIN_(layer)), T_, NPROJ, D_}; pg8::StaticOrder S; S.init(T_, NPROJ, gridDim.x, bid);
            EpiProj E{ws};
            pg8::gemm_phase<EpiProj, pg8::StaticOrder, true, true>(lds3, g, S, E, tid); }
        }
        else if (k == 2) {
            for (int rp = 0; rp < NREP(1); ++rp) { gdn_prep(a, layer, lds, tid, bid); }
            for (int rp = 0; rp < NREP(2); ++rp) lru_pass<false>(a, layer, lds, tid, bid);
        }
        else if (k == 3) { for (int rp = 0; rp < NREP(3); ++rp) { gdn_scan(a, layer, lds, tid, bid); __syncthreads(); } }
        else if (k == 4) {
            for (int rp = 0; rp < NREP(5); ++rp) lru_pass<true>(a, layer, lds, tid, bid);
        }
        else if (k == 5) { if (PHMASK & 64) {
            { pg8::Gemm g{(const bf16_t*)(ws + WS_OG), (const bf16_t*)(ws + WS_WBG_(layer)), T_, D_, 1024}; pg8::StaticOrder S; S.init(T_, D_, gridDim.x, bid);
              EpiGate E{(const bf16_t*)(ws + WS_SG), (bf16_t*)(ws + WS_MG), 0};
              pg8::gemm_phase<EpiGate, pg8::StaticOrder, true, true>(lds3, g, S, E, tid); }
            __syncthreads();
            { pg8::Gemm g{(const bf16_t*)(ws + WS_OL), (const bf16_t*)(ws + WS_WBL_(layer)), T_, D_, 1024}; pg8::StaticOrder S; S.init(T_, D_, gridDim.x, bid);
              EpiGate E{(const bf16_t*)(ws + WS_SG) + 2048, (bf16_t*)(ws + WS_MG), 1};
              pg8::gemm_phase<EpiGate, pg8::StaticOrder, true, true>(lds3, g, S, E, tid); } }
        }
        else if (k == 6) { if (PHMASK & 128) {
            pg8::Gemm g{(const bf16_t*)(ws + WS_MG), (const bf16_t*)(ws + WS_WOUT_(layer)), T_, D_, D_}; pg8::StaticOrder S; S.init(T_, D_, gridDim.x, bid);
            EpiRes E{xin, a->out};
            pg8::gemm_phase<EpiRes, pg8::StaticOrder, true, true>(lds3, g, S, E, tid); }
        }
        else if (k == 7) { for (int rp = 0; rp < NREP(7); ++rp) { phase_g(a, layer, a->out, lds, tid, bid); __syncthreads(); } }
        else if (k == 8) { if (PHMASK & 1024) {
            pg8::Gemm g{(const bf16_t*)(ws + WS_H), (const bf16_t*)(ws + WS_WUP), T_, DFF, D_}; pg8::StaticOrder S; S.init(T_, DFF, gridDim.x, bid);
            EpiRelu2 E{(bf16_t*)(ws + WS_UF)};
            pg8::gemm_phase<EpiRelu2, pg8::StaticOrder, true, true>(lds3, g, S, E, tid); }
        }
        else { if (PHMASK & 2048) {
            pg8::Gemm g{(const bf16_t*)(ws + WS_UF), (const bf16_t*)(ws + WS_WDN), T_, D_, DFF}; pg8::StaticOrder S; S.init(T_, D_, gridDim.x, bid);
            EpiRes E{a->out, a->out};
            pg8::gemm_phase<EpiRes, pg8::StaticOrder, true, true>(lds3, g, S, E, tid); }
        }
        if (ph + 1 < ph_hi) { if (ap->ph_hi < 0) cg::this_grid().sync();
            xcd_barrier(xbar); }
    }
}

extern "C" void kernel_launch(void* const* d_in, const int* in_sizes, int n_in, void* d_out, int out_size, void* d_ws, size_t ws_size, hipStream_t stream) {
    static int grid = 0;
    if (grid == 0) {
        if (n_in != 21 || ws_size < WS_END) { fprintf(stderr, "kernel_launch: unexpected n_in %d / ws_size %zu (need %zu)\n", n_in, ws_size, (size_t)WS_END); grid = -1; return; }
        int dev = 0, cus = 0, per_cu = 0;
        hipGetDevice(&dev); hipDeviceGetAttribute(&cus, hipDeviceAttributeMultiprocessorCount, dev);
        hipFuncSetAttribute((const void*)mega, hipFuncAttributeMaxDynamicSharedMemorySize, LDS_BYTES);
        if (hipOccupancyMaxActiveBlocksPerMultiprocessor(&per_cu, (const void*)mega, 512, LDS_BYTES) != hipSuccess || per_cu < 1) per_cu = 1;
        (void)hipGetLastError();
        grid = cus * per_cu;
    }
    if (grid < 0) return;
    Args a{};
    for (int i = 0; i < 21; ++i) a.in[i] = (const float*)d_in[i];
    a.out = (float*)d_out; a.ws = (unsigned char*)d_ws;
    (void)hipMemsetAsync((unsigned char*)d_ws + WS_CTL, 0, 16384, stream);
#if ONE_LAUNCH
    a.ph_lo = 0; a.ph_hi = NPH;
    void* args[] = {&a};
    hipError_t e = hipLaunchCooperativeKernel((const void*)mega, dim3(grid), dim3(512), args, LDS_BYTES, stream);
    if (e != hipSuccess) fprintf(stderr, "cooperative launch failed: %s (grid %d)\n", hipGetErrorString(e), grid);
#else
    for (int ph = 0; ph < NPH; ++ph) { a.ph_lo = ph; a.ph_hi = ph + 1; hipLaunchKernelGGL(mega, dim3(grid), dim3(512), LDS_BYTES, stream, a); }
#endif
}
```

```cpp
#include <hip/hip_runtime.h>
#include <hip/hip_cooperative_groups.h>
#include <cstdio>
#include <cstdint>
namespace cg = cooperative_groups;

#ifndef PHMASK
#define PHMASK 0xFFFF
#endif
#ifndef REPMASK
#define REPMASK 0
#endif
#ifndef REPSEL
#define REPSEL 0
#endif
#define NREP(x) ((REPSEL == (x)) ? 2 : 1)
#ifndef ONE_LAUNCH
#define ONE_LAUNCH 1
#endif

#define LAS __attribute__((address_space(3)))
typedef unsigned short bf16_t;
typedef short bf16x8 __attribute__((ext_vector_type(8)));
typedef float f32x4 __attribute__((ext_vector_type(4)));
typedef float f32x2 __attribute__((ext_vector_type(2)));
typedef unsigned u32x4 __attribute__((ext_vector_type(4)));
typedef unsigned u32x2 __attribute__((ext_vector_type(2)));

#define LDS_WAIT() asm volatile("s_waitcnt lgkmcnt(0)" ::: "memory")

typedef __bf16 bf16x2_t __attribute__((ext_vector_type(2)));
__device__ __forceinline__ unsigned cvt_pk_bf16(float lo, float hi) { f32x2 v = {lo, hi}; bf16x2_t r = __builtin_convertvector(v, bf16x2_t); return __builtin_bit_cast(unsigned, r); }
__device__ __forceinline__ unsigned short bf16_1(float x) { return (unsigned short)(cvt_pk_bf16(x, 0.f) & 0xffffu); }
__device__ __forceinline__ float bflo(unsigned w) { return __uint_as_float(w << 16); }
__device__ __forceinline__ float bfhi(unsigned w) { return __uint_as_float(w & 0xffff0000u); }
__device__ __forceinline__ void unpack8(const u32x4 w, float* f) { f[0] = bflo(w.x); f[1] = bfhi(w.x); f[2] = bflo(w.y); f[3] = bfhi(w.y); f[4] = bflo(w.z); f[5] = bfhi(w.z); f[6] = bflo(w.w); f[7] = bfhi(w.w); }
__device__ __forceinline__ u32x4 pack8(const float* f) { u32x4 w; w.x = cvt_pk_bf16(f[0], f[1]); w.y = cvt_pk_bf16(f[2], f[3]); w.z = cvt_pk_bf16(f[4], f[5]); w.w = cvt_pk_bf16(f[6], f[7]); return w; }
__device__ __forceinline__ float sigmoidf_(float x) { return __builtin_amdgcn_rcpf(1.0f + __expf(-x)); }
__device__ __forceinline__ float siluf_(float x) { return x * sigmoidf_(x); }
__device__ __forceinline__ float gelu_tanh(float x) { const float u = 0.7978845608028654f * (x + 0.044715f * x * x * x); return x * sigmoidf_(2.0f * u); }
__device__ __forceinline__ float softplusf_(float x) { return x > 20.f ? x : log1pf(expf(x)); }
__device__ __forceinline__ float wave_sum(float v) {
#pragma unroll
    for (int o = 1; o < 64; o <<= 1) v += __shfl_xor(v, o);
    return v;
}


__device__ __forceinline__ void grid_bar(unsigned* ctr, const unsigned target, const int tid) {
    asm volatile("s_waitcnt vmcnt(0) lgkmcnt(0)" ::: "memory");
    __syncthreads();
    if (tid == 0) {
        __builtin_amdgcn_fence(__ATOMIC_RELEASE, "agent");
        asm volatile("s_waitcnt vmcnt(0)" ::: "memory");
        __hip_atomic_fetch_add(ctr, 1u, __ATOMIC_RELAXED, __HIP_MEMORY_SCOPE_AGENT);
        while (__hip_atomic_load(ctr, __ATOMIC_RELAXED, __HIP_MEMORY_SCOPE_AGENT) < target) __builtin_amdgcn_s_sleep(1);
        __builtin_amdgcn_fence(__ATOMIC_ACQUIRE, "agent");
        asm volatile("s_waitcnt vmcnt(0)" ::: "memory");
    }
    __syncthreads();
}


typedef __attribute__((address_space(1))) unsigned gu32;
#define XB_TMO      128
#define XB_XCNT(j)  (256  + 64 * (j))
#define XB_XSUB(j)  (1280 + 64 * (j))
#define XB_XGEN(j)  (2304 + 64 * (j))
#define XB_TOP      3328
#define XB_TOPGEN   3392
#define XCD_BAR_WORDS 3456
#define XB_SPIN_CAP (1u << 18)

__device__ __forceinline__ unsigned xb_ld(unsigned* p)              { return __hip_atomic_load(p, __ATOMIC_RELAXED, __HIP_MEMORY_SCOPE_AGENT); }
__device__ __forceinline__ unsigned xb_add(unsigned* p, unsigned v) { return __hip_atomic_fetch_add(p, v, __ATOMIC_RELAXED, __HIP_MEMORY_SCOPE_AGENT); }
__device__ __forceinline__ unsigned xb_xcc_id() { return (unsigned)__builtin_amdgcn_s_getreg((3 << 11) | 20) & 0xFu; }
#define XB_SPIN(cond, bar) do { unsigned _sp = 0; while (cond) { __builtin_amdgcn_s_sleep(1); \
    if ((++_sp & 255u) == 0u) { if (xb_ld(&(bar)[XB_TMO])) break; if (_sp > XB_SPIN_CAP) { atomicAdd(&(bar)[XB_TMO], 1u); break; } } } } while (0)

struct XcdBarrier {
    unsigned* bar; unsigned x;
    volatile LAS unsigned* st;
};

__device__ __forceinline__ XcdBarrier xcd_barrier_post(unsigned* bar, volatile LAS unsigned* st) {
    XcdBarrier b; b.bar = bar; b.x = xb_xcc_id(); b.st = st;
    if (threadIdx.x == 0) (void)xb_add(&bar[XB_XCNT(b.x)], 1u);
    return b;
}
__device__ __forceinline__ void xcd_barrier_complete(unsigned* bar, unsigned x, unsigned& nloc, unsigned& nx) {
    const unsigned G = gridDim.x * gridDim.y * gridDim.z;
    unsigned sum, cnt, mine, sp = 0u;
    for (;;) {
        sum = 0u; cnt = 0u; mine = 0u;
#pragma unroll
        for (unsigned j = 0; j < 16; ++j) { const unsigned c = xb_ld(&bar[XB_XCNT(j)]); sum += c; cnt += (c > 0u) ? 1u : 0u; mine = (j == x) ? c : mine; }
        if (sum == G) break;
        __builtin_amdgcn_s_sleep(1);
        if ((++sp & 255u) == 0u) { if (xb_ld(&bar[XB_TMO])) break; if (sp > XB_SPIN_CAP) { atomicAdd(&bar[XB_TMO], 1u); break; } }
    }
    nloc = mine > 0u ? mine : 1u; nx = cnt > 0u ? cnt : 1u;
}

__device__ __forceinline__ void xcd_barrier(const XcdBarrier& b) {
    asm volatile("s_waitcnt vmcnt(0)" ::: "memory");
    __syncthreads();
    if (threadIdx.x == 0) {
        unsigned* bar = b.bar;
        __builtin_amdgcn_s_waitcnt(0);
        unsigned nloc = b.st[0], nx = b.st[1];
        if (nloc == 0u) { xcd_barrier_complete(bar, b.x, nloc, nx); b.st[0] = nloc; b.st[1] = nx; }
        const unsigned old = xb_add(&bar[XB_XSUB(b.x)], 1u);
        const unsigned gen = old / nloc;
        if (old + 1u == (gen + 1u) * nloc) {
            __builtin_amdgcn_fence(__ATOMIC_RELEASE, "agent");
            asm volatile("s_waitcnt vmcnt(0)" ::: "memory");
            const unsigned og = xb_add(&bar[XB_TOP], 1u);
            const unsigned tg = og / nx;
            if (og + 1u == (tg + 1u) * nx) xb_add(&bar[XB_TOPGEN], 1u);
            else XB_SPIN(xb_ld(&bar[XB_TOPGEN]) == tg, bar);
            __builtin_amdgcn_fence(__ATOMIC_ACQUIRE, "agent");
            xb_add(&bar[XB_XGEN(b.x)], 1u);
            asm volatile("s_waitcnt vmcnt(0)" ::: "memory");
        } else {
            XB_SPIN(xb_ld(&bar[XB_XGEN(b.x)]) == gen, bar);
            __builtin_amdgcn_fence(__ATOMIC_ACQUIRE, "agent");
            asm volatile("s_waitcnt vmcnt(0)" ::: "memory");
        }
    }
    __syncthreads();
}


namespace pg8 {
constexpr int BM = 256, BK = 64, HALF = 128, HTB = HALF * BK * 2, STAGE_BYTES = 8 * HTB, NXCD = 8, WGM = 8;
__host__ __device__ __forceinline__ int lds_byte(int r, int c) { const int st = (r >> 4) * 2 + (c >> 5), rr = r & 15, cc = c & 31, ob = rr * 64 + cc * 2; return st * 1024 + (ob ^ (((ob >> 9) & 1) << 5)); }
__host__ __device__ __forceinline__ void stage_rc(int b, int& R, int& C) { const int st = b / 1024, sb = b % 1024, swz = sb ^ (((sb >> 9) & 1) << 5); R = (st >> 1) * 16 + swz / 64; C = (st & 1) * 32 + (swz % 64) / 2; }
__host__ __device__ __forceinline__ int perm32(int rho) { const int n = rho >> 4, i = rho & 15; return 8 * (i >> 2) + 4 * n + (i & 3); }

struct Unit { int pm, pn; };
struct Gemm { const bf16_t* A; const bf16_t* Bt; int M, N, K; };

struct StaticOrder {
    int nM, nN, nwg, G, c;
    __host__ __device__ void init(int M, int N, int G_, int c_) { nM = M / BM; nN = N / BM; nwg = nM * nN; G = G_; c = c_; }
    __host__ __device__ bool next(int i, Unit& u) const {
        const long L = (long)i * G + c; if (L >= nwg) return false;
        int wgid = (int)L; { const int q = nwg / NXCD, r = nwg % NXCD, xcd = wgid % NXCD, off = wgid / NXCD; wgid = (xcd < r ? xcd * (q + 1) : r * (q + 1) + (xcd - r) * q) + off; }
        const int nig = WGM * nN, gid = wgid / nig, fm = gid * WGM, gsz = (nM - fm) < WGM ? (nM - fm) : WGM;
        u.pm = fm + ((wgid % nig) % gsz); u.pn = (wgid % nig) / gsz; return true;
    }
    __device__ __forceinline__ void a_ready(const Unit&) const {}
    __device__ __forceinline__ void done(const Unit&) const {}
};

struct HalfOrder : StaticOrder {
    int pm0;
    __device__ __forceinline__ bool next(int i, Unit& u) const { const bool ok = StaticOrder::next(i, u); u.pm += pm0; return ok; }
};

template <class Epi, class Sched, bool ALIGN_EPI = false, bool SP2 = false>
__device__ __forceinline__ void gemm_phase(LAS unsigned char* lds, const Gemm g, const Sched& S, const Epi& E, const int tid_) {
    const int tid = tid_, wid = __builtin_amdgcn_readfirstlane(tid >> 6), lane = tid & 63, wr = wid >> 2, wc = wid & 3, fr = lane & 15, fq = lane >> 4;
    const int K = g.K, nt = K / BK;
    unsigned voffA[2], voffB[2];
#pragma unroll
    for (int i = 0; i < 2; ++i) { int R, C; stage_rc(tid * 16 + i * 8192, R, C); const int Rb = Epi::PERM ? ((R & ~31) + perm32(R & 31)) : R;
        voffA[i] = (unsigned)(R * K + C) * 2u; voffB[i] = (unsigned)(Rb * K + C) * 2u; }
    const size_t kstep = (size_t)(BK * 2);
    const size_t hstep = (size_t)HALF * K * 2;
    const size_t tstep = 2 * hstep;
    const unsigned ldsw = (unsigned)wid * 1024u;
    const int aoff = lds_byte(wr * 64 + fr, fq * 8), boff = lds_byte(wc * 32 + fr, fq * 8);
#define PG8_SA(b, h) (((b) * 2 + (h)) * HTB)
#define PG8_SB(b, h) ((4 + (b) * 2 + (h)) * HTB)
#define PG8_STAGE(bufoff, gbase, voff) do { _Pragma("unroll") for (int _i = 0; _i < 2; ++_i) \
        __builtin_amdgcn_global_load_lds((const unsigned*)((const char*)(gbase) + (voff)[_i]), (LAS unsigned*)(lds + (bufoff) + ldsw + _i * 8192), 16, 0, 0); } while (0)
#define PG8_LDA(dst, b, h) do { _Pragma("unroll") for (int m = 0; m < 4; ++m) _Pragma("unroll") for (int k = 0; k < 2; ++k) dst[m][k] = *(const LAS bf16x8*)(lds + PG8_SA(b, h) + aoff + m * 2048 + k * 1024); } while (0)
#define PG8_LDB(dst, b, h) do { _Pragma("unroll") for (int n = 0; n < 2; ++n) _Pragma("unroll") for (int k = 0; k < 2; ++k) dst[n][k] = *(const LAS bf16x8*)(lds + PG8_SB(b, h) + boff + n * 2048 + k * 1024); } while (0)
#define PG8_MMA(ai, bj, At, Bt) do { __builtin_amdgcn_s_setprio(1); _Pragma("unroll") for (int m = 0; m < 4; ++m) _Pragma("unroll") for (int n = 0; n < 2; ++n) _Pragma("unroll") for (int k = 0; k < 2; ++k) \
        acc[ai][bj][m][n] = __builtin_amdgcn_mfma_f32_16x16x32_bf16(Bt[n][k], At[m][k], acc[ai][bj][m][n], 0, 0, 0); __builtin_amdgcn_s_setprio(0); } while (0)
#define PG8_WAIT_V(n) asm volatile("s_waitcnt vmcnt(" #n ")" ::: "memory")
#define PG8_WAIT_L(n) asm volatile("s_waitcnt lgkmcnt(" #n ")" ::: "memory")
#define PG8_BAR __builtin_amdgcn_s_barrier()
#define PG8_SCHED __builtin_amdgcn_sched_barrier(0)
    Unit cur, nxt; int ui = 0;
    if (!S.next(0, cur)) return;
    f32x4 acc[2][2][4][2];
#pragma unroll
    for (int a = 0; a < 2; ++a)
#pragma unroll
        for (int b = 0; b < 2; ++b)
#pragma unroll
            for (int m = 0; m < 4; ++m)
#pragma unroll
                for (int n = 0; n < 2; ++n) acc[a][b][m][n] = (f32x4){0.f, 0.f, 0.f, 0.f};
    bf16x8 At[4][2], B0[2][2], B1[2][2];
    const char* cA = (const char*)g.A + (size_t)cur.pm * tstep; const char* cB = (const char*)g.Bt + (size_t)cur.pn * tstep;
    S.a_ready(cur);
    if constexpr (SP2) {
        PG8_STAGE(PG8_SB(0, 0), cB, voffB); PG8_STAGE(PG8_SB(0, 1), cB + hstep, voffB); PG8_STAGE(PG8_SA(0, 0), cA, voffA); PG8_STAGE(PG8_SA(0, 1), cA + hstep, voffA);
        if (wr == 1) PG8_BAR;
        PG8_WAIT_V(2); PG8_BAR;
        PG8_STAGE(PG8_SB(1, 0), cB + kstep, voffB); PG8_STAGE(PG8_SA(1, 0), cA + kstep, voffA); PG8_STAGE(PG8_SB(1, 1), cB + hstep + kstep, voffB);
        PG8_WAIT_V(6); PG8_BAR;
    } else {
        PG8_STAGE(PG8_SB(0, 0), cB, voffB); PG8_STAGE(PG8_SA(0, 0), cA, voffA); PG8_STAGE(PG8_SB(0, 1), cB + hstep, voffB); PG8_STAGE(PG8_SA(0, 1), cA + hstep, voffA);
        if (wr == 1) PG8_BAR;
        PG8_WAIT_V(4); PG8_BAR;
        PG8_STAGE(PG8_SB(1, 0), cB + kstep, voffB); PG8_STAGE(PG8_SA(1, 0), cA + kstep, voffA); PG8_STAGE(PG8_SB(1, 1), cB + hstep + kstep, voffB);
        PG8_WAIT_V(6); PG8_BAR;
    }
    for (;;) {
        const bool has_next = S.next(ui + 1, nxt);
        const char* nA = has_next ? (const char*)g.A + (size_t)nxt.pm * tstep : cA; const char* nB = has_next ? (const char*)g.Bt + (size_t)nxt.pn * tstep : cB;
        for (int t = 0; t < nt; t += 2) {
            const bool last = (t == nt - 2);
            const char* a1 = cA + (size_t)(t + 1) * kstep;
            const char* a2 = last ? nA : cA + (size_t)(t + 2) * kstep; const char* b2 = last ? nB : cB + (size_t)(t + 2) * kstep;
            const char* a3 = a2 + kstep; const char* b3 = b2 + kstep;
            if (last && has_next) S.a_ready(nxt);
            if constexpr (SP2) {
            PG8_LDB(B0, 0, 0); PG8_LDB(B1, 0, 1); PG8_SCHED; PG8_LDA(At, 0, 0); PG8_STAGE(PG8_SA(1, 1), a1 + hstep, voffA);
            PG8_WAIT_V(8); PG8_WAIT_L(0); PG8_BAR; PG8_MMA(0, 0, At, B0); PG8_MMA(0, 1, At, B1); PG8_BAR; PG8_SCHED;
            PG8_LDA(At, 0, 1); PG8_STAGE(PG8_SB(0, 0), b2, voffB); PG8_STAGE(PG8_SB(0, 1), b2 + hstep, voffB); PG8_STAGE(PG8_SA(0, 0), a2, voffA);
            PG8_WAIT_V(8); PG8_WAIT_L(0); PG8_BAR; PG8_MMA(1, 0, At, B0); PG8_MMA(1, 1, At, B1); PG8_BAR; PG8_SCHED;
            PG8_LDB(B0, 1, 0); PG8_LDB(B1, 1, 1); PG8_SCHED; PG8_LDA(At, 1, 0); PG8_STAGE(PG8_SA(0, 1), a2 + hstep, voffA);
            PG8_WAIT_V(8); PG8_WAIT_L(0); PG8_BAR; PG8_MMA(0, 0, At, B0); PG8_MMA(0, 1, At, B1); PG8_BAR; PG8_SCHED;
            PG8_LDA(At, 1, 1); PG8_STAGE(PG8_SB(1, 0), b3, voffB); PG8_STAGE(PG8_SB(1, 1), b3 + hstep, voffB); PG8_STAGE(PG8_SA(1, 0), a3, voffA);
            PG8_WAIT_V(8); PG8_WAIT_L(0); PG8_BAR; PG8_MMA(1, 0, At, B0); PG8_MMA(1, 1, At, B1); PG8_BAR; PG8_SCHED;
            } else {
            PG8_LDB(B0, 0, 0); PG8_SCHED; PG8_LDA(At, 0, 0); PG8_STAGE(PG8_SA(1, 1), a1 + hstep, voffA);
            PG8_WAIT_L(8); PG8_BAR; PG8_WAIT_L(0); PG8_MMA(0, 0, At, B0); PG8_BAR; PG8_SCHED;
            PG8_LDB(B1, 0, 1); PG8_STAGE(PG8_SB(0, 0), b2, voffB);
            PG8_BAR; PG8_WAIT_L(0); PG8_MMA(0, 1, At, B1); PG8_BAR;
            PG8_LDA(At, 0, 1); PG8_STAGE(PG8_SA(0, 0), a2, voffA);
            PG8_BAR; PG8_WAIT_L(0); PG8_MMA(1, 0, At, B0); PG8_BAR; PG8_SCHED;
            PG8_STAGE(PG8_SB(0, 1), b2 + hstep, voffB);
            PG8_WAIT_V(6); PG8_BAR; PG8_MMA(1, 1, At, B1); PG8_BAR;
            PG8_LDB(B0, 1, 0); PG8_SCHED; PG8_LDA(At, 1, 0); PG8_STAGE(PG8_SA(0, 1), a2 + hstep, voffA);
            PG8_WAIT_L(8); PG8_BAR; PG8_WAIT_L(0); PG8_MMA(0, 0, At, B0); PG8_BAR; PG8_SCHED;
            PG8_LDB(B1, 1, 1); PG8_STAGE(PG8_SB(1, 0), b3, voffB);
            PG8_BAR; PG8_WAIT_L(0); PG8_MMA(0, 1, At, B1); PG8_BAR;
            PG8_LDA(At, 1, 1); PG8_STAGE(PG8_SA(1, 0), a3, voffA);
            PG8_BAR; PG8_WAIT_L(0); PG8_MMA(1, 0, At, B0); PG8_BAR; PG8_SCHED;
            PG8_STAGE(PG8_SB(1, 1), b3 + hstep, voffB);
            PG8_WAIT_V(6); PG8_BAR; PG8_MMA(1, 1, At, B1); PG8_BAR;
            }
        }
        if constexpr (ALIGN_EPI) { if (wr == 0) PG8_BAR; }
        E(acc, cur, wr, wc, fr, fq); S.done(cur);
        if (!has_next) break;
#pragma unroll
        for (int a = 0; a < 2; ++a)
#pragma unroll
            for (int b = 0; b < 2; ++b)
#pragma unroll
                for (int m = 0; m < 4; ++m)
#pragma unroll
                    for (int n = 0; n < 2; ++n) acc[a][b][m][n] = (f32x4){0.f, 0.f, 0.f, 0.f};
        cur = nxt; cA = nA; cB = nB; ++ui;
        if constexpr (ALIGN_EPI) { if (wr == 1) PG8_BAR; }
    }
    PG8_WAIT_V(0);
    if constexpr (!ALIGN_EPI) { if (wr == 0) PG8_BAR; }
    PG8_BAR;
#undef PG8_SA
#undef PG8_SB
#undef PG8_STAGE
#undef PG8_LDA
#undef PG8_LDB
#undef PG8_MMA
#undef PG8_WAIT_V
#undef PG8_WAIT_L
#undef PG8_BAR
#undef PG8_SCHED
}
}

constexpr int T_ = 16384, D_ = 2048, SEQ_ = 4096, NPROJ = 10240, INC = 10256, DFF = 8192;
constexpr size_t MiB = (size_t)1 << 20;
constexpr size_t WS_G = 0;
constexpr size_t WS_BETA = MiB / 2;
constexpr size_t WS_AGGA = 1 * MiB;
constexpr size_t WS_AGGB = 2 * MiB;
__device__ __forceinline__ size_t WS_LWA_(int l) { return l ? 144 * MiB : 3 * MiB; }
__device__ __forceinline__ size_t WS_LWX_(int l) { return l ? 144 * MiB + 512 * 1024 : 3 * MiB + 512 * 1024; }
__device__ __forceinline__ size_t WS_WOUT_(int l) { return l ? 128 * MiB : 8 * MiB; }
__device__ __forceinline__ size_t WS_WBG_(int l) { return l ? 136 * MiB : 16 * MiB; }
__device__ __forceinline__ size_t WS_WBL_(int l) { return l ? 140 * MiB : 20 * MiB; }
__device__ __forceinline__ size_t WS_WIN_(int l) { return l ? 88 * MiB : 536 * MiB; }
constexpr size_t WS_CTL = 5 * MiB;
constexpr size_t WS_EGL = 4 * MiB;
constexpr size_t WS_H = 152 * MiB;
constexpr size_t WS_U = 152 * MiB, WS_W = 184 * MiB, WS_MG = 152 * MiB;
constexpr size_t WS_QKV = 216 * MiB;
constexpr size_t WS_Z = 312 * MiB;
constexpr size_t WS_XB = 344 * MiB;
constexpr size_t WS_YB = 376 * MiB;
constexpr size_t WS_SG = 408 * MiB;
constexpr size_t WS_ORAW = 280 * MiB;
constexpr size_t WS_OG = 216 * MiB, WS_OL = 248 * MiB;
constexpr size_t WS_UF = 216 * MiB;
constexpr size_t WS_QD = 536 * MiB, WS_KDT = 568 * MiB, WS_QK = 600 * MiB;
constexpr size_t WS_WUP = 24 * MiB, WS_WDN = 56 * MiB;
constexpr size_t WS_END = 616 * MiB;
constexpr int LDS_BYTES = 131072 + 4096;

struct Args { const float* in[21]; float* out; unsigned char* ws; int ph_lo, ph_hi; };
typedef const __attribute__((address_space(4))) Args* KA;

struct EpiProj {
    static constexpr bool PERM = true;
    unsigned char* ws;
    __device__ __forceinline__ void operator()(const f32x4 (&acc)[2][2][4][2], const pg8::Unit& u, int wr, int wc, int fr, int fq) const {
        const int pn = u.pn; bf16_t* base; int ldc, colt; bool sig = false;
        if (pn < 12) { base = (bf16_t*)(ws + WS_QKV); ldc = 3072; colt = pn * 256; }
        else if (pn < 16) { base = (bf16_t*)(ws + WS_Z); ldc = 1024; colt = (pn - 12) * 256; }
        else if (pn < 20) { base = (bf16_t*)(ws + WS_XB); ldc = 1024; colt = (pn - 16) * 256; }
        else if (pn < 24) { base = (bf16_t*)(ws + WS_YB); ldc = 1024; colt = (pn - 20) * 256; }
        else { base = (bf16_t*)(ws + WS_SG); ldc = 4096; colt = (pn - 24) * 256; sig = true; }
        const int row0 = u.pm * 256 + wr * 64 + fr, col0 = colt + wc * 32 + 8 * fq;
#pragma unroll
        for (int ai = 0; ai < 2; ++ai)
#pragma unroll
            for (int m = 0; m < 4; ++m) { bf16_t* rowp = base + (size_t)(row0 + ai * 128 + m * 16) * ldc + col0;
#pragma unroll
                for (int bj = 0; bj < 2; ++bj) { f32x4 v0 = acc[ai][bj][m][0], v1 = acc[ai][bj][m][1];
                    if (sig) {
#pragma unroll
                        for (int j = 0; j < 4; ++j) { v0[j] = sigmoidf_(v0[j]); v1[j] = sigmoidf_(v1[j]); } }
                    u32x4 w; w.x = cvt_pk_bf16(v0[0], v0[1]); w.y = cvt_pk_bf16(v0[2], v0[3]); w.z = cvt_pk_bf16(v1[0], v1[1]); w.w = cvt_pk_bf16(v1[2], v1[3]);
                    *(u32x4*)(rowp + bj * 128) = w; } }
    }
};
struct EpiNull { static constexpr bool PERM = true; float* o;
    __device__ __forceinline__ void operator()(const f32x4 (&acc)[2][2][4][2], const pg8::Unit& u, int wr, int wc, int fr, int fq) const { if (acc[0][0][0][0][0] == 12345.678f) o[0] = 1.f; } };
struct EpiGate {
    static constexpr bool PERM = true;
    const bf16_t* sg; bf16_t* mg; int add;
    __device__ __forceinline__ void operator()(const f32x4 (&acc)[2][2][4][2], const pg8::Unit& u, int wr, int wc, int fr, int fq) const {
        const int row0 = u.pm * 256 + wr * 64 + fr, col0 = u.pn * 256 + wc * 32 + 8 * fq;
#pragma unroll
        for (int ai = 0; ai < 2; ++ai)
#pragma unroll
            for (int mh = 0; mh < 2; ++mh) {
                u32x4 gwv[2][2], pwv[2][2];
#pragma unroll
                for (int m2 = 0; m2 < 2; ++m2) { const size_t r = (size_t)(row0 + ai * 128 + (2 * mh + m2) * 16);
#pragma unroll
                    for (int bj = 0; bj < 2; ++bj) { gwv[m2][bj] = *(const u32x4*)(sg + r * 4096 + col0 + bj * 128);
                        pwv[m2][bj] = add ? *(const u32x4*)(mg + r * 2048 + col0 + bj * 128) : (u32x4){0u, 0u, 0u, 0u}; } }
                asm volatile("" ::: "memory");
#pragma unroll
                for (int m2 = 0; m2 < 2; ++m2) { const size_t r = (size_t)(row0 + ai * 128 + (2 * mh + m2) * 16);
#pragma unroll
                    for (int bj = 0; bj < 2; ++bj) {
                        float gf[8], pf[8], of[8]; unpack8(gwv[m2][bj], gf); unpack8(pwv[m2][bj], pf);
                        const f32x4 v0 = acc[ai][bj][2 * mh + m2][0], v1 = acc[ai][bj][2 * mh + m2][1];
#pragma unroll
                        for (int j = 0; j < 4; ++j) { of[j] = gf[j] * v0[j] + pf[j]; of[4 + j] = gf[4 + j] * v1[j] + pf[4 + j]; }
                        *(u32x4*)(mg + r * 2048 + col0 + bj * 128) = pack8(of); } }
                asm volatile("" ::: "memory");
            }
    }
};
struct EpiRes {
    static constexpr bool PERM = false;
    const float* res; float* out;
    __device__ __forceinline__ void operator()(const f32x4 (&acc)[2][2][4][2], const pg8::Unit& u, int wr, int wc, int fr, int fq) const {
        const int row0 = u.pm * 256 + wr * 64 + fr, col0 = u.pn * 256 + wc * 32 + 4 * fq;
#pragma unroll
        for (int ai = 0; ai < 2; ++ai) {
            f32x4 r[4][2][2];
#pragma unroll
            for (int m = 0; m < 4; ++m) { const size_t off = (size_t)(row0 + ai * 128 + m * 16) * 2048 + col0;
#pragma unroll
                for (int bj = 0; bj < 2; ++bj)
#pragma unroll
                    for (int n = 0; n < 2; ++n) r[m][bj][n] = *(const f32x4*)(res + off + bj * 128 + n * 16); }
            asm volatile("" ::: "memory");
#pragma unroll
            for (int m = 0; m < 4; ++m) { const size_t off = (size_t)(row0 + ai * 128 + m * 16) * 2048 + col0;
#pragma unroll
                for (int bj = 0; bj < 2; ++bj)
#pragma unroll
                    for (int n = 0; n < 2; ++n) *(f32x4*)(out + off + bj * 128 + n * 16) = r[m][bj][n] + acc[ai][bj][m][n]; }
            asm volatile("" ::: "memory");
        }
    }
};
struct EpiRelu2 {
    static constexpr bool PERM = true;
    bf16_t* O;
    __device__ __forceinline__ void operator()(const f32x4 (&acc)[2][2][4][2], const pg8::Unit& u, int wr, int wc, int fr, int fq) const {
        const int row0 = u.pm * 256 + wr * 64 + fr, col0 = u.pn * 256 + wc * 32 + 8 * fq;
#pragma unroll
        for (int ai = 0; ai < 2; ++ai)
#pragma unroll
            for (int m = 0; m < 4; ++m) { bf16_t* rowp = O + (size_t)(row0 + ai * 128 + m * 16) * DFF + col0;
#pragma unroll
                for (int bj = 0; bj < 2; ++bj) { f32x4 v0 = acc[ai][bj][m][0], v1 = acc[ai][bj][m][1];
#pragma unroll
                    for (int j = 0; j < 4; ++j) { const float a = fmaxf(v0[j], 0.f), b = fmaxf(v1[j], 0.f); v0[j] = a * a; v1[j] = b * b; }
                    u32x4 w; w.x = cvt_pk_bf16(v0[0], v0[1]); w.y = cvt_pk_bf16(v0[2], v0[3]); w.z = cvt_pk_bf16(v1[0], v1[1]); w.w = cvt_pk_bf16(v1[2], v1[3]);
                    *(u32x4*)(rowp + bj * 128) = w; } }
    }
};

__device__ __forceinline__ void transpose_tile(const float* src, size_t ldw, bf16_t* dst, size_t ldk, float* scr, int lane) {
    f32x4 v[8];
#pragma unroll
    for (int i = 0; i < 8; ++i) v[i] = *(const f32x4*)(src + (size_t)((lane >> 3) + 8 * i) * ldw + 4 * (lane & 7));
#pragma unroll
    for (int i = 0; i < 8; ++i) { float* p = scr + ((lane >> 3) + 8 * i) * 33 + 4 * (lane & 7); p[0] = v[i].x; p[1] = v[i].y; p[2] = v[i].z; p[3] = v[i].w; }
    LDS_WAIT();
    const int c = lane & 7;
#pragma unroll
    for (int j = 0; j < 4; ++j) { const int n = (lane >> 3) + 8 * j; const float* s = scr + (8 * c) * 33 + n;
        u32x4 o; o.x = cvt_pk_bf16(s[0 * 33], s[1 * 33]); o.y = cvt_pk_bf16(s[2 * 33], s[3 * 33]); o.z = cvt_pk_bf16(s[4 * 33], s[5 * 33]); o.w = cvt_pk_bf16(s[6 * 33], s[7 * 33]);
        *(u32x4*)(dst + (size_t)n * ldk + 8 * c) = o; }
    LDS_WAIT();
}
__device__ __forceinline__ void transpose_item(const float* W, int K, int N, bf16_t* WT, int item, float* scr, int lane) {
    const int nblk = N / 32, kb = item / nblk, nb = item % nblk;
    transpose_tile(W + (size_t)(64 * kb) * N + 32 * nb, (size_t)N, WT + (size_t)(32 * nb) * K + 64 * kb, (size_t)K, scr, lane);
}

__device__ __forceinline__ void phase_a(KA a, int layer, const float* xin, unsigned char* lds, const int tid_, const int bid_) {
    const int tid = tid_, lane = tid & 63, wave = tid >> 6;
    const int gw = bid_ * 8 + wave, NGW = gridDim.x * 8;
    unsigned char* ws = a->ws;
    float* scr = (float*)(lds + wave * 16384);
    const float* w_in = a->in[2] + (size_t)layer * D_ * INC;
    {
        constexpr int I_IN = 32 * 320, I_OUT = 32 * 64, I_BR = 16 * 64, I_L = 64;
        constexpr int NIT = I_IN + I_OUT + 2 * I_BR + 2 * I_L;
        for (int it = gw; it < NIT; it += NGW) {
            int r = it; const float* sp; bf16_t* dp; size_t ldw, ldk;
            if (r < I_IN) { const int kb = r / 320, nb = r % 320; const int sc = 32 * nb + (nb >= 128 ? 16 : 0);
                sp = w_in + (size_t)(64 * kb) * INC + sc; ldw = INC; dp = (bf16_t*)(ws + WS_WIN_(layer)) + (size_t)(32 * nb) * D_ + 64 * kb; ldk = D_; }
            else { r -= I_IN; const float* W; bf16_t* WT; int K, N;
                if (r < I_OUT) { W = a->in[16] + (size_t)layer * D_ * D_; K = D_; N = D_; WT = (bf16_t*)(ws + WS_WOUT_(layer)); }
                else { r -= I_OUT;
                    if (r < I_BR) { W = a->in[14] + (size_t)layer * 1024 * D_; K = 1024; N = D_; WT = (bf16_t*)(ws + WS_WBG_(layer)); }
                    else { r -= I_BR;
                        if (r < I_BR) { W = a->in[15] + (size_t)layer * 1024 * D_; K = 1024; N = D_; WT = (bf16_t*)(ws + WS_WBL_(layer)); }
                        else { r -= I_BR; K = 128; N = 128;
                            if (r < I_L) { const int n = r >> 3; W = a->in[9] + (size_t)(layer * 8 + n) * 16384; WT = (bf16_t*)(ws + WS_LWA_(layer)) + n * 16384; r &= 7; }
                            else { r -= I_L; const int n = r >> 3; W = a->in[11] + (size_t)(layer * 8 + n) * 16384; WT = (bf16_t*)(ws + WS_LWX_(layer)) + n * 16384; r &= 7; } } } }
                const int nblk = N / 32, kb = r / nblk, nb = r % nblk;
                sp = W + (size_t)(64 * kb) * N + 32 * nb; ldw = N; dp = WT + (size_t)(32 * nb) * K + 64 * kb; ldk = K; }
            transpose_tile(sp, ldw, dp, ldk, scr, lane);
            asm volatile("" ::: "memory");
        }
    }
    __syncthreads();
    bf16_t* WlT = (bf16_t*)lds;
    for (int idx = tid; idx < D_ * 16; idx += 512) { const int k = idx >> 4, j = idx & 15; WlT[j * 2056 + k] = bf16_1(w_in[(size_t)k * INC + 4096 + j]); }
    __syncthreads();
    const float* gain = a->in[1] + (size_t)layer * D_;
    f32x4 gn[8];
#pragma unroll
    for (int j = 0; j < 8; ++j) gn[j] = ((const f32x4*)gain)[64 * j + lane];
    const int fr = lane & 15, fq = lane >> 4;
    const float a_log = a->in[4][layer * 8 + (fr & 7)], dtb = a->in[5][layer * 8 + (fr & 7)];
    bf16_t* H = (bf16_t*)(ws + WS_H);
    float* G = (float*)(ws + WS_G); float* BETA = (float*)(ws + WS_BETA);
    for (int grp = gw; grp < T_ / 8; grp += NGW) {
        const int row0 = grp * 8;
        for (int r8 = 0; r8 < 8; ++r8) {
            const int m = row0 + r8;
            const f32x4* xr = (const f32x4*)(xin + (size_t)m * D_) + lane;
            f32x4 v[8]; float ss = 0.f;
#pragma unroll
            for (int j = 0; j < 8; ++j) { v[j] = xr[64 * j]; ss += (v[j].x * v[j].x + v[j].y * v[j].y) + (v[j].z * v[j].z + v[j].w * v[j].w); }
            ss = wave_sum(ss);
            const float rstd = rsqrtf(ss * (1.0f / D_) + 1e-6f);
            u32x2* o8 = (u32x2*)(H + (size_t)m * D_) + lane;
#pragma unroll
            for (int j = 0; j < 8; ++j) { v[j] = v[j] * rstd * gn[j]; u32x2 w; w.x = cvt_pk_bf16(v[j].x, v[j].y); w.y = cvt_pk_bf16(v[j].z, v[j].w); o8[64 * j] = w; }
        }
        asm volatile("s_waitcnt vmcnt(0)" ::: "memory");
        f32x4 acc = (f32x4){0.f, 0.f, 0.f, 0.f};
        const bf16_t* arow = H + (size_t)(row0 + (fr & 7)) * D_ + 8 * fq;
#pragma unroll 4
        for (int kb = 0; kb < 8; ++kb) {
            bf16x8 A[8];
#pragma unroll
            for (int q = 0; q < 8; ++q) A[q] = *(const bf16x8*)(arow + 32 * (kb * 8 + q));
#pragma unroll
            for (int q = 0; q < 8; ++q) acc = __builtin_amdgcn_mfma_f32_16x16x32_bf16(A[q], *(const bf16x8*)(WlT + fr * 2056 + 32 * (kb * 8 + q) + 8 * fq), acc, 0, 0, 0);
        }
        if (fq < 2) {
#pragma unroll
            for (int j = 0; j < 4; ++j) { const int m = row0 + 4 * fq + j;
                if (fr < 8) G[(size_t)m * 8 + fr] = -expf(a_log) * softplusf_(acc[j] + dtb);
                else BETA[(size_t)m * 8 + (fr - 8)] = sigmoidf_(acc[j]); }
        }
    }
}

__device__ __forceinline__ void phase_g(KA a, int layer, const float* x1, unsigned char* lds, const int tid_, const int bid_) {
    const int tid = tid_, lane = tid & 63, wave = tid >> 6;
    const int gw = bid_ * 8 + wave, NGW = gridDim.x * 8;
    unsigned char* ws = a->ws;
    float* scr = (float*)(lds + wave * 16384);
    for (int it = gw; it < 16384; it += NGW) {
        const bool up = it < 8192; const int r = up ? it : it - 8192;
        const float* W = up ? a->in[18] + (size_t)layer * D_ * DFF : a->in[19] + (size_t)layer * DFF * D_;
        bf16_t* WT = (bf16_t*)(ws + (up ? WS_WUP : WS_WDN)); const int K = up ? D_ : DFF, N = up ? DFF : D_;
        const int nblk = N / 32, kb = r / nblk, nb = r % nblk;
        transpose_tile(W + (size_t)(64 * kb) * N + 32 * nb, (size_t)N, WT + (size_t)(32 * nb) * K + 64 * kb, (size_t)K, scr, lane);
        asm volatile("" ::: "memory");
    }
    const float* gain = a->in[17] + (size_t)layer * D_;
    f32x4 gn[8];
#pragma unroll
    for (int j = 0; j < 8; ++j) gn[j] = ((const f32x4*)gain)[64 * j + lane];
    bf16_t* H = (bf16_t*)(ws + WS_H);
    for (int m = gw; m < T_; m += NGW) {
        const f32x4* xr = (const f32x4*)(x1 + (size_t)m * D_) + lane;
        f32x4 v[8]; float ss = 0.f;
#pragma unroll
        for (int j = 0; j < 8; ++j) { v[j] = xr[64 * j]; ss += (v[j].x * v[j].x + v[j].y * v[j].y) + (v[j].z * v[j].z + v[j].w * v[j].w); }
        ss = wave_sum(ss);
        const float rstd = rsqrtf(ss * (1.0f / D_) + 1e-6f);
        u32x2* o8 = (u32x2*)(H + (size_t)m * D_) + lane;
#pragma unroll
        for (int j = 0; j < 8; ++j) { v[j] = v[j] * rstd * gn[j]; u32x2 w; w.x = cvt_pk_bf16(v[j].x, v[j].y); w.y = cvt_pk_bf16(v[j].z, v[j].w); o8[64 * j] = w; }
    }
}
__device__ __forceinline__ void phase_final(KA a, const float* x, const int tid_, const int bid_) {
    const int tid = tid_, lane = tid & 63, wave = tid >> 6;
    const int gw = bid_ * 8 + wave, NGW = gridDim.x * 8;
    const float* gain = a->in[20];
    f32x4 gn[8];
#pragma unroll
    for (int j = 0; j < 8; ++j) gn[j] = ((const f32x4*)gain)[64 * j + lane];
    for (int m = gw; m < T_; m += NGW) {
        const f32x4* xr = (const f32x4*)(x + (size_t)m * D_) + lane;
        f32x4 v[8]; float ss = 0.f;
#pragma unroll
        for (int j = 0; j < 8; ++j) { v[j] = xr[64 * j]; ss += (v[j].x * v[j].x + v[j].y * v[j].y) + (v[j].z * v[j].z + v[j].w * v[j].w); }
        ss = wave_sum(ss);
        const float rstd = rsqrtf(ss * (1.0f / D_) + 1e-6f);
        f32x4* o = (f32x4*)(a->out + (size_t)m * D_) + lane;
#pragma unroll
        for (int j = 0; j < 8; ++j) o[64 * j] = v[j] * rstd * gn[j];
    }
}

__device__ __forceinline__ void gdn_prep(KA a, int layer, unsigned char* lds, const int tid_, const int bid_) {
    const int tid = tid_, lane = tid & 63, wave = tid >> 6, tl = tid >> 3, sub = tid & 7;
    unsigned char* ws = a->ws;
    const float* cw = a->in[3] + (size_t)layer * 4 * 3072;
    const bf16_t* QKV = (const bf16_t*)(ws + WS_QKV);
    const float* G = (const float*)(ws + WS_G); const float* BETA = (const float*)(ws + WS_BETA);
    unsigned char* Kb = lds; unsigned char* Qb = lds + 17408; float* Ls = (float*)(lds + 34816); float* RHS = (float*)(lds + 52224);
    float* gcs = (float*)(lds + 118784); float* bts = gcs + 64; unsigned char* QKs = lds + 119296; unsigned char* KDTs = lds;
    float* cwl = (float*)(lds + 128512);
    int h_loaded = -1;
    float g_nx = 0.f, b_nx = 0.f;
    if (wave == 0 && bid_ < 2048) { g_nx = G[(size_t)((bid_ >> 3) * 64 + lane) * 8 + (bid_ & 7)]; b_nx = BETA[(size_t)((bid_ >> 3) * 64 + lane) * 8 + (bid_ & 7)]; }
    for (int item = bid_; item < 2048; item += gridDim.x) {
        const int c = item >> 3, h = item & 7, tg0 = c * 64;
        const int tg = tg0 + tl, s = tg & (SEQ_ - 1);
        if (h != h_loaded) {
            if (tid < 384) { const int pj = tid >> 5, q4 = tid & 31; *(f32x4*)(cwl + pj * 128 + q4 * 4) = *(const f32x4*)(cw + (pj & 3) * 3072 + (pj >> 2) * 1024 + h * 128 + q4 * 4); }
            h_loaded = h;
            __syncthreads();
        }
        u32x4 xr[2][4][2];
#define PREP_LOAD(p) do { _Pragma("unroll") for (int j = 0; j < 4; ++j) { const int rowi = (s - 3 + j >= 0) ? tg - 3 + j : tg; const bf16_t* row = QKV + (size_t)rowi * 3072 + (p) * 1024 + h * 128 + 16 * sub; \
                xr[(p) & 1][j][0] = *(const u32x4*)row; xr[(p) & 1][j][1] = *(const u32x4*)(row + 8); } } while (0)
        PREP_LOAD(0); PREP_LOAD(1);
        if (wave == 0) {
            float g = g_nx; const float bt = b_nx;
            const int nit = item + gridDim.x;
            if (nit < 2048) { g_nx = G[(size_t)((nit >> 3) * 64 + lane) * 8 + (nit & 7)]; b_nx = BETA[(size_t)((nit >> 3) * 64 + lane) * 8 + (nit & 7)]; }
#pragma unroll
            for (int o = 1; o < 64; o <<= 1) { const float t = __shfl_up(g, o); if (lane >= o) g += t; }
            gcs[lane] = g; bts[lane] = bt;
            if (lane == 63) ((float*)(ws + WS_EGL))[item] = expf(g);
        }
        float qkv[3][16];
#pragma unroll
        for (int p = 0; p < 3; ++p) {
#pragma unroll
            for (int e = 0; e < 16; ++e) qkv[p][e] = 0.f;
#pragma unroll
            for (int j = 0; j < 4; ++j) {
                const float vm = (s - 3 + j >= 0) ? 1.0f : 0.0f;
                float x[16]; unpack8(xr[p & 1][j][0], x); unpack8(xr[p & 1][j][1], x + 8);
                const f32x4* wp = (const f32x4*)(cwl + (p * 4 + j) * 128 + 16 * sub);
#pragma unroll
                for (int q = 0; q < 4; ++q) { const f32x4 w4 = wp[q] * vm; qkv[p][4 * q] += w4.x * x[4 * q]; qkv[p][4 * q + 1] += w4.y * x[4 * q + 1]; qkv[p][4 * q + 2] += w4.z * x[4 * q + 2]; qkv[p][4 * q + 3] += w4.w * x[4 * q + 3]; }
            }
            if (p == 0) { asm volatile("" ::: "memory"); PREP_LOAD(2); }
#pragma unroll
            for (int e = 0; e < 16; ++e) qkv[p][e] = siluf_(qkv[p][e]);
            if (p < 2) {
                float ss = 0.f;
#pragma unroll
                for (int e = 0; e < 16; ++e) ss += qkv[p][e] * qkv[p][e];
                ss += __shfl_xor(ss, 1); ss += __shfl_xor(ss, 2); ss += __shfl_xor(ss, 4);
                const float sc = rsqrtf(ss + 1e-6f) * (p == 0 ? 0.08838834764831845f : 1.0f);
#pragma unroll
                for (int e = 0; e < 16; ++e) qkv[p][e] *= sc;
            }
        }
        __syncthreads();
        const float gci = gcs[tl], gl = gcs[63], bi = bts[tl];
        const float eg = __expf(gci), ekd = __expf(gl - gci);
        *(u32x4*)(Kb + tl * 272 + sub * 32) = pack8(qkv[1]); *(u32x4*)(Kb + tl * 272 + sub * 32 + 16) = pack8(qkv[1] + 8);
        *(u32x4*)(Qb + tl * 272 + sub * 32) = pack8(qkv[0]); *(u32x4*)(Qb + tl * 272 + sub * 32 + 16) = pack8(qkv[0] + 8);
#pragma unroll
        for (int q = 0; q < 4; ++q) {
            *(f32x4*)(RHS + tl * 260 + 16 * sub + 4 * q) = (f32x4){bi * qkv[2][4 * q], bi * qkv[2][4 * q + 1], bi * qkv[2][4 * q + 2], bi * qkv[2][4 * q + 3]};
            const float bk = bi * eg;
            *(f32x4*)(RHS + tl * 260 + 128 + 16 * sub + 4 * q) = (f32x4){bk * qkv[1][4 * q], bk * qkv[1][4 * q + 1], bk * qkv[1][4 * q + 2], bk * qkv[1][4 * q + 3]};
        }
        {
            float qd[16];
#pragma unroll
            for (int e = 0; e < 16; ++e) { qd[e] = qkv[0][e] * eg; qkv[1][e] *= ekd; }
            bf16_t* dst = (bf16_t*)(ws + WS_QD) + (size_t)tg * 1024 + h * 128 + 16 * sub;
            *(u32x4*)dst = pack8(qd); *(u32x4*)(dst + 8) = pack8(qd + 8);
        }
        __syncthreads();
        {
            const int fr = lane & 15, fq = lane >> 4, ti = wave >> 1, tj0 = (wave & 1) * 2;
            bf16x8 Ak[4], Aq[4];
#pragma unroll
            for (int ks = 0; ks < 4; ++ks) { Ak[ks] = *(const bf16x8*)(Kb + (16 * ti + fr) * 272 + (32 * ks + 8 * fq) * 2); Aq[ks] = *(const bf16x8*)(Qb + (16 * ti + fr) * 272 + (32 * ks + 8 * fq) * 2); }
#pragma unroll
            for (int jj = 0; jj < 2; ++jj) {
                const int tj = tj0 + jj;
                f32x4 ckk = (f32x4){0.f, 0.f, 0.f, 0.f}, cqk = (f32x4){0.f, 0.f, 0.f, 0.f};
#pragma unroll
                for (int ks = 0; ks < 4; ++ks) { const bf16x8 B = *(const bf16x8*)(Kb + (16 * tj + fr) * 272 + (32 * ks + 8 * fq) * 2);
                    ckk = __builtin_amdgcn_mfma_f32_16x16x32_bf16(Ak[ks], B, ckk, 0, 0, 0); cqk = __builtin_amdgcn_mfma_f32_16x16x32_bf16(Aq[ks], B, cqk, 0, 0, 0); }
                const int jc = 16 * tj + fr; const float gj = gcs[jc];
#pragma unroll
                for (int j = 0; j < 4; ++j) { const int i = 16 * ti + 4 * fq + j; const float gi = gcs[i], bti = bts[i];
                    const float e = __expf(i >= jc ? gi - gj : 0.f);
                    Ls[i * 68 + jc] = (i > jc) ? bti * ckk[j] * e : 0.f;
                    ((bf16_t*)QKs)[i * 72 + jc] = bf16_1((i >= jc) ? cqk[j] * e : 0.f); }
            }
        }
        __syncthreads();
#pragma unroll
        for (int e = 0; e < 16; ++e) ((bf16_t*)KDTs)[(16 * sub + e) * 72 + ((((tl >> 3) ^ sub) << 3) | (tl & 7))] = bf16_1(qkv[1][e]);
        if (tid < 256) {
            float x[64];
#pragma unroll
            for (int i = 0; i < 64; ++i) x[i] = RHS[i * 260 + tid];
            f32x4 bufA[8], bufB[8];
#define SUB_LROW(buf, i_, j0_, n_) do { _Pragma("unroll") for (int j4 = 0; j4 < (n_); ++j4) buf[j4] = *(const f32x4*)(Ls + (i_) * 68 + 4 * ((j0_) + j4)); } while (0)
#define SUB_FROW(buf, j0_, n_) do { _Pragma("unroll") for (int j4 = 0; j4 < (n_); ++j4) { const f32x4 l = buf[j4]; \
                acc -= l.x * x[4 * ((j0_) + j4)]; acc -= l.y * x[4 * ((j0_) + j4) + 1]; acc -= l.z * x[4 * ((j0_) + j4) + 2]; acc -= l.w * x[4 * ((j0_) + j4) + 3]; } } while (0)
#pragma unroll
            for (int j4 = 0; j4 < 8; ++j4) { bufA[j4] = (f32x4){0.f, 0.f, 0.f, 0.f}; bufB[j4] = (f32x4){0.f, 0.f, 0.f, 0.f}; }
            SUB_LROW(bufA, 1, 0, 1);
#pragma unroll
            for (int i = 1; i <= 32; ++i) {
                const int nn = (i + 4) / 4 < 8 ? (i + 4) / 4 : 8;
                float acc = x[i];
                if (i & 1) { SUB_LROW(bufB, i + 1, 0, nn); __builtin_amdgcn_sched_barrier(0); SUB_FROW(bufA, 0, (i + 3) / 4); }
                else       { SUB_LROW(bufA, i + 1, 0, nn); __builtin_amdgcn_sched_barrier(0); SUB_FROW(bufB, 0, (i + 3) / 4); }
                x[i] = acc;
                __builtin_amdgcn_sched_barrier(0);
            }
#pragma unroll
            for (int i = 33; i < 64; ++i) {
                float acc = x[i];
                SUB_LROW(bufB, i, 8, (i + 3) / 4 - 8); __builtin_amdgcn_sched_barrier(0);
                SUB_FROW(bufA, 0, 8); __builtin_amdgcn_sched_barrier(0);
                if (i + 1 < 64) SUB_LROW(bufA, i + 1, 0, 8);
                __builtin_amdgcn_sched_barrier(0);
                SUB_FROW(bufB, 8, (i + 3) / 4 - 8);
                x[i] = acc;
                __builtin_amdgcn_sched_barrier(0);
            }
#undef SUB_LROW
#undef SUB_FROW
#pragma unroll
            for (int i = 0; i < 64; ++i) RHS[i * 260 + tid] = x[i];
        } else {
            const int t2 = tid - 256;
#pragma unroll
            for (int r = 0; r < 2; ++r) { const int idx = t2 + 256 * r; *(u32x4*)((bf16_t*)(ws + WS_QK) + (size_t)item * 4096 + idx * 8) = *(const u32x4*)(QKs + (idx >> 3) * 144 + (idx & 7) * 16); }
        }
        __syncthreads();
        {
            float xu[16], xw[16];
#pragma unroll
            for (int q = 0; q < 4; ++q) { const f32x4 u4 = *(const f32x4*)(RHS + tl * 260 + 16 * sub + 4 * q), w4 = *(const f32x4*)(RHS + tl * 260 + 128 + 16 * sub + 4 * q);
                xu[4 * q] = u4.x; xu[4 * q + 1] = u4.y; xu[4 * q + 2] = u4.z; xu[4 * q + 3] = u4.w; xw[4 * q] = w4.x; xw[4 * q + 1] = w4.y; xw[4 * q + 2] = w4.z; xw[4 * q + 3] = w4.w; }
            bf16_t* du = (bf16_t*)(ws + WS_U) + (size_t)tg * 1024 + h * 128 + 16 * sub; bf16_t* dw = (bf16_t*)(ws + WS_W) + (size_t)tg * 1024 + h * 128 + 16 * sub;
            *(u32x4*)du = pack8(xu); *(u32x4*)(du + 8) = pack8(xu + 8); *(u32x4*)dw = pack8(xw); *(u32x4*)(dw + 8) = pack8(xw + 8);
#pragma unroll
            for (int r = 0; r < 2; ++r) { const int idx = tid + 512 * r; *(u32x4*)((bf16_t*)(ws + WS_KDT) + (size_t)item * 8192 + idx * 8) = *(const u32x4*)(KDTs + (idx >> 3) * 144 + (((idx & 7) ^ ((idx >> 7) & 7)) * 16)); }
        }
        __syncthreads();
    }
}

__device__ __forceinline__ void gdn_scan(KA a, int layer, unsigned char* lds, const int tid_, const int bid_) {
    const int tid = tid_, lane = tid & 63, wave = __builtin_amdgcn_readfirstlane(tid >> 6), fr = lane & 15, fq = lane >> 4;
    unsigned char* ws = a->ws;
    for (int wi = bid_; wi < 256; wi += gridDim.x) {
    const int q = wi >> 3, bh = (wi & 7) * 4 + (q & 3), slice = q >> 2, b = bh >> 3, h = bh & 7;
    unsigned char* Wl = lds; unsigned char* QDl = lds + 17408; unsigned char* KDTl = lds + 34816; unsigned char* QKl = lds + 53248;
    unsigned char* Ul = lds + 62464; unsigned char* SlT = lds + 64512; unsigned char* VNT = lds + 68864;
    const bf16_t* Wg = (const bf16_t*)(ws + WS_W); const bf16_t* QDg = (const bf16_t*)(ws + WS_QD); const bf16_t* Ug = (const bf16_t*)(ws + WS_U);
    const bf16_t* KDTg = (const bf16_t*)(ws + WS_KDT); const bf16_t* QKg = (const bf16_t*)(ws + WS_QK); const float* EGL = (const float*)(ws + WS_EGL);
    bf16_t* ORAW = (bf16_t*)(ws + WS_ORAW);
    const int i = wave & 3; const bool isQ = wave >= 4;
    const unsigned char* abase = isQ ? QDl : Wl;
    f32x4 S = (f32x4){0.f, 0.f, 0.f, 0.f}, out = (f32x4){0.f, 0.f, 0.f, 0.f};
    u32x4 rW[2], rQD[2], rK[2], rQK, rU; float egl_cur, egl_next = 0.f;
    rU = (u32x4){0u, 0u, 0u, 0u};
#define GS_LOAD_A(n) do { const int tg0_ = b * SEQ_ + (n) * 64; \
        _Pragma("unroll") for (int r = 0; r < 2; ++r) { const int idx = tid + 512 * r; const size_t off = (size_t)(tg0_ + (idx >> 4)) * 1024 + h * 128 + (idx & 15) * 8; \
            rW[r] = *(const u32x4*)(Wg + off); rQD[r] = *(const u32x4*)(QDg + off); } \
        if (tid < 128) rU = *(const u32x4*)(Ug + (size_t)(tg0_ + (tid >> 1)) * 1024 + h * 128 + slice * 16 + (tid & 1) * 8); } while (0)
#define GS_STORE_A() do { _Pragma("unroll") for (int r = 0; r < 2; ++r) { const int idx = tid + 512 * r; const int o1 = (idx >> 4) * 272 + (idx & 15) * 16; \
            *(u32x4*)(Wl + o1) = rW[r]; *(u32x4*)(QDl + o1) = rQD[r]; } \
        if (tid < 128) *(u32x4*)(Ul + (tid >> 1) * 32 + (tid & 1) * 16) = rU; } while (0)
#define GS_LOAD_B(n) do { const int item_ = ((b * 64 + (n)) * 8 + h); \
        _Pragma("unroll") for (int r = 0; r < 2; ++r) { const int idx = tid + 512 * r; rK[r] = *(const u32x4*)(KDTg + (size_t)item_ * 8192 + idx * 8); } \
        rQK = *(const u32x4*)(QKg + (size_t)item_ * 4096 + tid * 8); egl_next = EGL[item_]; } while (0)
#define GS_STORE_B() do { _Pragma("unroll") for (int r = 0; r < 2; ++r) { const int idx = tid + 512 * r; *(u32x4*)(KDTl + (idx >> 3) * 144 + (idx & 7) * 16) = rK[r]; } \
        *(u32x4*)(QKl + (tid >> 3) * 144 + (tid & 7) * 16) = rQK; } while (0)
    GS_LOAD_A(0); GS_LOAD_B(0); GS_STORE_A(); GS_STORE_B(); egl_cur = egl_next;
    if (tid < 272) *(u32x4*)(SlT + tid * 16) = (u32x4){0u, 0u, 0u, 0u};
    GS_LOAD_A(1);
    __syncthreads();
    for (int n = 0; n < 64; ++n) {
        const int tg0 = b * SEQ_ + n * 64;
        {
            f32x4 acc = (f32x4){0.f, 0.f, 0.f, 0.f};
#pragma unroll
            for (int ks = 0; ks < 4; ++ks)
                acc = __builtin_amdgcn_mfma_f32_16x16x32_bf16(*(const bf16x8*)(abase + (16 * i + fr) * 272 + (32 * ks + 8 * fq) * 2), *(const bf16x8*)(SlT + fr * 272 + (32 * ks + 8 * fq) * 2), acc, 0, 0, 0);
            if (!isQ) {
                float vn[4];
#pragma unroll
                for (int j = 0; j < 4; ++j) { const float u = __uint_as_float(((unsigned)*(const bf16_t*)(Ul + (16 * i + 4 * fq + j) * 32 + fr * 2)) << 16); vn[j] = u - acc[j]; }
                u32x2 w; w.x = cvt_pk_bf16(vn[0], vn[1]); w.y = cvt_pk_bf16(vn[2], vn[3]);
                *(u32x2*)(VNT + fr * 144 + (16 * i + 4 * fq) * 2) = w;
            } else out = acc;
        }
        if (n > 0) { GS_STORE_B(); egl_cur = egl_next; }
        if (n + 1 < 64) GS_LOAD_B(n + 1);
        __syncthreads();
        {
            bf16x8 Bv[2];
#pragma unroll
            for (int ks = 0; ks < 2; ++ks) Bv[ks] = *(const bf16x8*)(VNT + fr * 144 + (32 * ks + 8 * fq) * 2);
            f32x4 accS = S * egl_cur;
#pragma unroll
            for (int ks = 0; ks < 2; ++ks) accS = __builtin_amdgcn_mfma_f32_16x16x32_bf16(*(const bf16x8*)(KDTl + (16 * wave + fr) * 144 + (32 * ks + 8 * fq) * 2), Bv[ks], accS, 0, 0, 0);
            S = accS;
            { u32x2 w; w.x = cvt_pk_bf16(S[0], S[1]); w.y = cvt_pk_bf16(S[2], S[3]); *(u32x2*)(SlT + fr * 272 + (16 * wave + 4 * fq) * 2) = w; }
            if (isQ) {
#pragma unroll
                for (int ks = 0; ks < 2; ++ks) out = __builtin_amdgcn_mfma_f32_16x16x32_bf16(*(const bf16x8*)(QKl + (16 * i + fr) * 144 + (32 * ks + 8 * fq) * 2), Bv[ks], out, 0, 0, 0);
#pragma unroll
                for (int j = 0; j < 4; ++j) ORAW[(size_t)(tg0 + 16 * i + 4 * fq + j) * 1024 + h * 128 + 16 * slice + fr] = bf16_1(out[j]);
            }
        }
        if (n + 1 < 64) { GS_STORE_A(); if (n + 2 < 64) GS_LOAD_A(n + 2); }
        __syncthreads();
    }
    __syncthreads();
    }
#undef GS_LOAD_A
#undef GS_STORE_A
#undef GS_LOAD_B
#undef GS_STORE_B
}
__device__ __forceinline__ void gdn_norm(KA a, int layer, const int tid_, const int bid_) {
    const int tid = tid_, tl = tid >> 3, sub = tid & 7;
    unsigned char* ws = a->ws;
    const float* ng = a->in[6] + layer * 128 + 16 * sub;
    for (int item = bid_; item < 2048; item += gridDim.x) {
        const int c = item >> 3, h = item & 7;
        const size_t go = (size_t)(c * 64 + tl) * 1024 + h * 128 + 16 * sub;
        float o[16], zf[16]; float ms = 0.f;
        { const u32x4 o0 = *(const u32x4*)((const bf16_t*)(ws + WS_ORAW) + go), o1 = *(const u32x4*)((const bf16_t*)(ws + WS_ORAW) + go + 8); unpack8(o0, o); unpack8(o1, o + 8); }
#pragma unroll
        for (int e = 0; e < 16; ++e) ms += o[e] * o[e];
        ms += __shfl_xor(ms, 1); ms += __shfl_xor(ms, 2); ms += __shfl_xor(ms, 4);
        const float r = rsqrtf(ms * (1.0f / 128.0f) + 1e-6f);
        { const u32x4 z0 = *(const u32x4*)((const bf16_t*)(ws + WS_Z) + go), z1 = *(const u32x4*)((const bf16_t*)(ws + WS_Z) + go + 8); unpack8(z0, zf); unpack8(z1, zf + 8); }
#pragma unroll
        for (int e = 0; e < 16; ++e) o[e] = o[e] * r * ng[e] * siluf_(zf[e]);
        bf16_t* dst = (bf16_t*)(ws + WS_OG) + go;
        *(u32x4*)dst = pack8(o); *(u32x4*)(dst + 8) = pack8(o + 8);
    }
}

template <bool P3>
__device__ __forceinline__ void lru_pass(KA a, int layer, unsigned char* lds, const int tid_, const int bid_) {
    const int tid = tid_, lane = tid & 63, wave = tid >> 6, tl = tid >> 3, sub = tid & 7, fr = lane & 15, fq = lane >> 4;
    unsigned char* ws = a->ws;
    float* XCF = (float*)lds; float* AL = XCF + 8448; bf16_t* XCB = (bf16_t*)(AL + 8448); float* CP = (float*)((unsigned char*)XCB + 17408);
    float* lcw = CP + 1024;
    float* SEG = lcw + 640;
    const bf16_t* XB = (const bf16_t*)(ws + WS_XB);
    float* AGGA = (float*)(ws + WS_AGGA); float* AGGB = (float*)(ws + WS_AGGB);
    int n_loaded = -1;
    bf16x8 Ba[4], Bx[4]; float ba = 0.f, bx = 0.f, spl = 0.f;
#pragma unroll
    for (int ks = 0; ks < 4; ++ks) { Ba[ks] = (bf16x8){0, 0, 0, 0, 0, 0, 0, 0}; Bx[ks] = (bf16x8){0, 0, 0, 0, 0, 0, 0, 0}; }
    for (int item = bid_; item < 2048; item += gridDim.x) {
        const int c = item >> 3, n = item & 7;
        const int tg = c * 64 + tl, s = tg & (SEQ_ - 1), ch0 = n * 128 + 16 * sub;
        u32x4 xr[4][2];
#pragma unroll
        for (int j = 0; j < 4; ++j) { const int rowi = (s - 3 + j >= 0) ? tg - 3 + j : tg; const bf16_t* row = XB + (size_t)rowi * 1024 + ch0; xr[j][0] = *(const u32x4*)row; xr[j][1] = *(const u32x4*)(row + 8); }
        u32x4 yr0 = (u32x4){0u, 0u, 0u, 0u}, yr1 = yr0;
        u32x4 go0 = yr0, go1 = yr0, gz0 = yr0, gz1 = yr0;
        float Ap = 1.f, Bp = 0.f;
        if (P3) {
            { const size_t gq = (size_t)tg * 1024 + ch0; const bf16_t* op = (const bf16_t*)(ws + WS_ORAW) + gq; const bf16_t* zp = (const bf16_t*)(ws + WS_Z) + gq;
              go0 = *(const u32x4*)op; go1 = *(const u32x4*)(op + 8); gz0 = *(const u32x4*)zp; gz1 = *(const u32x4*)(zp + 8); }
            const bf16_t* yrow = (const bf16_t*)(ws + WS_YB) + (size_t)tg * 1024 + ch0; yr0 = *(const u32x4*)yrow; yr1 = *(const u32x4*)(yrow + 8);
            const int chl = tid & 127, part = tid >> 7; const int cb0 = (c & ~63) + part * 16;
            float av[16], bv[16];
#pragma unroll
            for (int i = 0; i < 16; ++i) { const int cc = cb0 + i; const int ci = cc < c ? cc : c; av[i] = AGGA[(size_t)ci * 1024 + n * 128 + chl]; bv[i] = AGGB[(size_t)ci * 1024 + n * 128 + chl]; }
#pragma unroll
            for (int i = 0; i < 16; ++i) { if (cb0 + i < c) { Bp = av[i] * Bp + bv[i]; Ap = av[i] * Ap; } }
        }
        if (n != n_loaded) {
            if (tid < 160) { const int j = tid >> 5, q4 = tid & 31; *(f32x4*)(lcw + j * 128 + q4 * 4) = (j < 4) ? *(const f32x4*)(a->in[7] + (size_t)(layer * 4 + j) * 1024 + n * 128 + q4 * 4) : *(const f32x4*)(a->in[8] + layer * 1024 + n * 128 + q4 * 4); }
            const bf16_t* wa = (const bf16_t*)(ws + WS_LWA_(layer)) + (size_t)(n * 128 + 16 * wave + fr) * 128 + fq * 8;
            const bf16_t* wx = (const bf16_t*)(ws + WS_LWX_(layer)) + (size_t)(n * 128 + 16 * wave + fr) * 128 + fq * 8;
#pragma unroll
            for (int ks = 0; ks < 4; ++ks) { Ba[ks] = *(const bf16x8*)(wa + ks * 32); Bx[ks] = *(const bf16x8*)(wx + ks * 32); }
            const int ch = n * 128 + 16 * wave + fr;
            ba = a->in[10][layer * 1024 + ch]; bx = a->in[12][layer * 1024 + ch]; spl = softplusf_(-a->in[13][layer * 1024 + ch]);
            n_loaded = n;
            __syncthreads();
        }
        {
            float xc[16];
#pragma unroll
            for (int q = 0; q < 4; ++q) { const f32x4 b4 = *(const f32x4*)(lcw + 4 * 128 + 16 * sub + 4 * q); xc[4 * q] = b4.x; xc[4 * q + 1] = b4.y; xc[4 * q + 2] = b4.z; xc[4 * q + 3] = b4.w; }
#pragma unroll
            for (int j = 0; j < 4; ++j) {
                const float vm = (s - 3 + j >= 0) ? 1.0f : 0.0f;
                float x[16]; unpack8(xr[j][0], x); unpack8(xr[j][1], x + 8);
#pragma unroll
                for (int q = 0; q < 4; ++q) { const f32x4 w4 = *(const f32x4*)(lcw + j * 128 + 16 * sub + 4 * q) * vm; xc[4 * q] += w4.x * x[4 * q]; xc[4 * q + 1] += w4.y * x[4 * q + 1]; xc[4 * q + 2] += w4.z * x[4 * q + 2]; xc[4 * q + 3] += w4.w * x[4 * q + 3]; }
            }
#pragma unroll
            for (int q = 0; q < 4; ++q) *(f32x4*)(XCF + tl * 132 + 16 * sub + 4 * q) = (f32x4){xc[4 * q], xc[4 * q + 1], xc[4 * q + 2], xc[4 * q + 3]};
            *(u32x4*)(XCB + tl * 136 + 16 * sub) = pack8(xc); *(u32x4*)(XCB + tl * 136 + 16 * sub + 8) = pack8(xc + 8);
            if (P3) { CP[((tid >> 7) * 128 + (tid & 127)) * 2] = Ap; CP[((tid >> 7) * 128 + (tid & 127)) * 2 + 1] = Bp; }
        }
        __syncthreads();
        {
            f32x4 accA[4], accX[4];
#pragma unroll
            for (int tile = 0; tile < 4; ++tile) { accA[tile] = (f32x4){0.f, 0.f, 0.f, 0.f}; accX[tile] = (f32x4){0.f, 0.f, 0.f, 0.f};
#pragma unroll
                for (int ks = 0; ks < 4; ++ks) { const bf16x8 A = *(const bf16x8*)(XCB + (tile * 16 + fr) * 136 + ks * 32 + fq * 8);
                    accA[tile] = __builtin_amdgcn_mfma_f32_16x16x32_bf16(A, Ba[ks], accA[tile], 0, 0, 0);
                    accX[tile] = __builtin_amdgcn_mfma_f32_16x16x32_bf16(A, Bx[ks], accX[tile], 0, 0, 0); } }
            const int chl = 16 * wave + fr;
#pragma unroll
            for (int tile = 0; tile < 4; ++tile)
#pragma unroll
                for (int j = 0; j < 4; ++j) { const int tok = tile * 16 + fq * 4 + j;
                    const float r = sigmoidf_(accA[tile][j] + ba), ig = sigmoidf_(accX[tile][j] + bx);
                    const float la = -8.0f * r * spl; const float av = __expf(la);
                    const float bt = __builtin_sqrtf(fmaxf(1.0f - av * av, 0.f)) * ig * XCF[tok * 132 + chl];
                    AL[tok * 132 + chl] = av; XCF[tok * 132 + chl] = bt; }
        }
        __syncthreads();
        {
            const int chl = tid & 127, seg = tid >> 7, t0 = seg * 16;
            float av[16], bv[16];
#pragma unroll
            for (int t = 0; t < 16; ++t) { av[t] = AL[(t0 + t) * 132 + chl]; bv[t] = XCF[(t0 + t) * 132 + chl]; }
            float hl = 0.f, Pl = 1.f;
#pragma unroll
            for (int t = 0; t < 16; ++t) { hl = av[t] * hl + bv[t]; Pl *= av[t]; }
            SEG[(seg * 128 + chl) * 2] = Pl; SEG[(seg * 128 + chl) * 2 + 1] = hl;
            __syncthreads();
            if (P3) {
                float h = 0.f;
#pragma unroll
                for (int part = 0; part < 4; ++part) h = CP[(part * 128 + chl) * 2] * h + CP[(part * 128 + chl) * 2 + 1];
#pragma unroll
                for (int s2 = 0; s2 < 3; ++s2) { if (s2 < seg) h = SEG[(s2 * 128 + chl) * 2] * h + SEG[(s2 * 128 + chl) * 2 + 1]; }
#pragma unroll
                for (int t = 0; t < 16; ++t) { h = av[t] * h + bv[t]; XCF[(t0 + t) * 132 + chl] = h; }
            } else if (tid < 128) {
                float h = 0.f, P = 1.f;
#pragma unroll
                for (int s2 = 0; s2 < 4; ++s2) { const float Ps = SEG[(s2 * 128 + tid) * 2], hs = SEG[(s2 * 128 + tid) * 2 + 1]; h = Ps * h + hs; P *= Ps; }
                AGGA[(size_t)c * 1024 + n * 128 + tid] = P; AGGB[(size_t)c * 1024 + n * 128 + tid] = h;
            }
        }
        __syncthreads();
        if (P3) {
            float y[16], o[16]; unpack8(yr0, y); unpack8(yr1, y + 8);
#pragma unroll
            for (int e = 0; e < 16; ++e) o[e] = XCF[tl * 132 + 16 * sub + e] * gelu_tanh(y[e]);
            bf16_t* dst = (bf16_t*)(ws + WS_OL) + (size_t)tg * 1024 + ch0;
            *(u32x4*)dst = pack8(o); *(u32x4*)(dst + 8) = pack8(o + 8);
            {
                float go[16], zf[16]; unpack8(go0, go); unpack8(go1, go + 8); unpack8(gz0, zf); unpack8(gz1, zf + 8);
                float ms = 0.f;
#pragma unroll
                for (int e = 0; e < 16; ++e) ms += go[e] * go[e];
                ms += __shfl_xor(ms, 1); ms += __shfl_xor(ms, 2); ms += __shfl_xor(ms, 4);
                const float rn = rsqrtf(ms * (1.0f / 128.0f) + 1e-6f);
                const float* ngp = a->in[6] + layer * 128 + 16 * sub;
#pragma unroll
                for (int e = 0; e < 16; ++e) go[e] = go[e] * rn * ngp[e] * siluf_(zf[e]);
                bf16_t* gd = (bf16_t*)(ws + WS_OG) + (size_t)tg * 1024 + ch0;
                *(u32x4*)gd = pack8(go); *(u32x4*)(gd + 8) = pack8(go + 8);
            }
            __syncthreads();
        }
    }
}

template <int HF> __device__ __forceinline__ void ffn_up(unsigned char* ws, LAS unsigned char* lds3, const int tid, const int bid) {
    constexpr size_t r0 = (size_t)HF * 8192;
    pg8::Gemm g{(const bf16_t*)(ws + WS_H) + r0 * D_, (const bf16_t*)(ws + WS_WUP), T_ / 2, DFF, D_}; pg8::StaticOrder S; S.init(T_ / 2, DFF, gridDim.x, bid);
    EpiRelu2 E{(bf16_t*)(ws + WS_UF) + r0 * DFF};
    pg8::gemm_phase<EpiRelu2, pg8::StaticOrder, true, true>(lds3, g, S, E, tid);
}
template <int HF> __device__ __forceinline__ void ffn_down(unsigned char* ws, float* xo, LAS unsigned char* lds3, const int tid, const int bid) {
    constexpr size_t r0 = (size_t)HF * 8192;
    pg8::Gemm g{(const bf16_t*)(ws + WS_UF) + r0 * DFF, (const bf16_t*)(ws + WS_WDN), T_ / 2, D_, DFF}; pg8::StaticOrder S; S.init(T_ / 2, D_, gridDim.x, bid);
    EpiRes E{xo + r0 * D_, xo + r0 * D_};
    pg8::gemm_phase<EpiRes, pg8::StaticOrder, true, true>(lds3, g, S, E, tid);
}

constexpr int PERL = 12, NPH = 2 * PERL + 1;
__global__ void __launch_bounds__(512, 2) mega(Args a_) {
    extern __shared__ __attribute__((aligned(16))) unsigned char lds[];
    LAS unsigned char* lds3 = (LAS unsigned char*)lds;
    KA ap = (KA)__builtin_amdgcn_kernarg_segment_ptr();
    const int ph_hi = ap->ph_hi;
    volatile LAS unsigned* xb_st = (volatile LAS unsigned*)(lds3 + (LDS_BYTES - 16));
    if (threadIdx.x == 0) { xb_st[0] = 0u; xb_st[1] = 0u; }
    __syncthreads();
    XcdBarrier xbar = xcd_barrier_post((unsigned*)(ap->ws + WS_CTL) + 64, xb_st);
    for (int ph = ap->ph_lo; ph < ph_hi; ++ph) {
        const int layer = ph / PERL, k = ph % PERL;
        KA a = ap; asm volatile("" : "+s"(a));
        int tid = threadIdx.x; asm volatile("" : "+v"(tid));
        int bid = blockIdx.x; asm volatile("" : "+s"(bid));
        unsigned char* ws = a->ws;
        const float* xin = layer == 0 ? a->in[0] : a->out;
        if (ph == 2 * PERL) { if (PHMASK & 512) phase_final(a, a->out, tid, bid); }
        else if (k == 0) { for (int rp = 0; rp < NREP(6); ++rp) { phase_a(a, layer, xin, lds, tid, bid); __syncthreads(); } }
        else if (k == 1) { if (PHMASK & 2) {
            pg8::Gemm g{(const bf16_t*)(ws + WS_H), (const bf16_t*)(ws + WS_WIN_(layer)), T_, NPROJ, D_}; pg8::StaticOrder S; S.init(T_, NPROJ, gridDim.x, bid);
            EpiProj E{ws};
            pg8::gemm_phase<EpiProj, pg8::StaticOrder, true, true>(lds3, g, S, E, tid); }
        }
        else if (k == 2) {
            for (int rp = 0; rp < NREP(1); ++rp) { gdn_prep(a, layer, lds, tid, bid); }
            for (int rp = 0; rp < NREP(2); ++rp) lru_pass<false>(a, layer, lds, tid, bid);
        }
        else if (k == 3) { for (int rp = 0; rp < NREP(3); ++rp) { gdn_scan(a, layer, lds, tid, bid); __syncthreads(); } }
        else if (k == 4) {
            for (int rp = 0; rp < NREP(5); ++rp) lru_pass<true>(a, layer, lds, tid, bid);
        }
        else if (k == 5) { if (PHMASK & 64) {
            { pg8::Gemm g{(const bf16_t*)(ws + WS_OG), (const bf16_t*)(ws + WS_WBG_(layer)), T_, D_, 1024}; pg8::StaticOrder S; S.init(T_, D_, gridDim.x, bid);
              EpiGate E{(const bf16_t*)(ws + WS_SG), (bf16_t*)(ws + WS_MG), 0};
              pg8::gemm_phase<EpiGate, pg8::StaticOrder, true, true>(lds3, g, S, E, tid); }
            __syncthreads();
            { pg8::Gemm g{(const bf16_t*)(ws + WS_OL), (const bf16_t*)(ws + WS_WBL_(layer)), T_, D_, 1024}; pg8::StaticOrder S; S.init(T_, D_, gridDim.x, bid);
              EpiGate E{(const bf16_t*)(ws + WS_SG) + 2048, (bf16_t*)(ws + WS_MG), 1};
              pg8::gemm_phase<EpiGate, pg8::StaticOrder, true, true>(lds3, g, S, E, tid); } }
        }
        else if (k == 6) { if (PHMASK & 128) {
            pg8::Gemm g{(const bf16_t*)(ws + WS_MG), (const bf16_t*)(ws + WS_WOUT_(layer)), T_, D_, D_}; pg8::StaticOrder S; S.init(T_, D_, gridDim.x, bid);
            EpiRes E{xin, a->out};
            pg8::gemm_phase<EpiRes, pg8::StaticOrder, true, true>(lds3, g, S, E, tid); }
        }
        else if (k == 7) { for (int rp = 0; rp < NREP(7); ++rp) { phase_g(a, layer, a->out, lds, tid, bid); __syncthreads(); } }
        else if ((k & 1) == 0) {
            pg8::Gemm g{(const bf16_t*)(ws + WS_H), (const bf16_t*)(ws + WS_WUP), T_, DFF, D_}; pg8::HalfOrder S; S.init(T_ / 2, DFF, gridDim.x, bid); { int p0 = (ph % PERL) >= 10 ? 32 : 0; asm volatile("" : "+s"(p0)); S.pm0 = p0; }
            EpiRelu2 E{(bf16_t*)(ws + WS_UF)};
            pg8::gemm_phase<EpiRelu2, pg8::HalfOrder, true, true>(lds3, g, S, E, tid);
        }
        else {
            pg8::Gemm g{(const bf16_t*)(ws + WS_UF), (const bf16_t*)(ws + WS_WDN), T_, D_, DFF}; pg8::HalfOrder S; S.init(T_ / 2, D_, gridDim.x, bid); { int p0 = (ph % PERL) >= 10 ? 32 : 0; asm volatile("" : "+s"(p0)); S.pm0 = p0; }
            EpiRes E{a->out, a->out};
            pg8::gemm_phase<EpiRes, pg8::HalfOrder, true, true>(lds3, g, S, E, tid);
        }
        if (ph + 1 < ph_hi) { if (ap->ph_hi < 0) cg::this_grid().sync();
            xcd_barrier(xbar); }
    }
}

extern "C" void kernel_launch(void* const* d_in, const int* in_sizes, int n_in, void* d_out, int out_size, void* d_ws, size_t ws_size, hipStream_t stream) {
    static int grid = 0;
    if (grid == 0) {
        if (n_in != 21 || ws_size < WS_END) { fprintf(stderr, "kernel_launch: unexpected n_in %d / ws_size %zu (need %zu)\n", n_in, ws_size, (size_t)WS_END); grid = -1; return; }
        int dev = 0, cus = 0, per_cu = 0;
        hipGetDevice(&dev); hipDeviceGetAttribute(&cus, hipDeviceAttributeMultiprocessorCount, dev);
        hipFuncSetAttribute((const void*)mega, hipFuncAttributeMaxDynamicSharedMemorySize, LDS_BYTES);
        if (hipOccupancyMaxActiveBlocksPerMultiprocessor(&per_cu, (const void*)mega, 512, LDS_BYTES) != hipSuccess || per_cu < 1) per_cu = 1;
        (void)hipGetLastError();
        grid = cus * per_cu;
    }
    if (grid < 0) return;
    Args a{};
    for (int i = 0; i < 21; ++i) a.in[i] = (const float*)d_in[i];
    a.out = (float*)d_out; a.ws = (unsigned char*)d_ws;
    (void)hipMemsetAsync((unsigned char*)d_ws + WS_CTL, 0, 16384, stream);
#if ONE_LAUNCH
    a.ph_lo = 0; a.ph_hi = NPH;
    void* args[] = {&a};
    hipError_t e = hipLaunchCooperativeKernel((const void*)mega, dim3(grid), dim3(512), args, LDS_BYTES, stream);
    if (e != hipSuccess) fprintf(stderr, "cooperative launch failed: %s (grid %d)\n", hipGetErrorString(e), grid);
#else
    for (int ph = 0; ph < NPH; ++ph) { a.ph_lo = ph; a.ph_hi = ph + 1; hipLaunchKernelGGL(mega, dim3(grid), dim3(512), LDS_BYTES, stream, a); }
#endif
}
```
